# Optimizing an MI355X kernel written in HIP

```python
import math, functools
import jax, jax.numpy as jnp
from jax import lax
import numpy as np

D_MODEL = 1024
BATCH = 2
SEQ = 8192
DEPTH = 4
DEC_BATCH = 32
DEC_SEQ = 8
PAST_LEN = 8192
PAGE_SIZE = 128

HEAD_DIM = 64
A_WIDTH = D_MODEL // 4
C_WIDTH = 3 * D_MODEL // 8
B_WIDTH = D_MODEL - A_WIDTH - C_WIDTH
MIX_WIDTH = A_WIDTH + B_WIDTH + C_WIDTH
A_HEADS = A_WIDTH // HEAD_DIM
C_HEADS = C_WIDTH // HEAD_DIM
CHUNK = 128
SSM_GROUP = 16
B_GROUPS = B_WIDTH // SSM_GROUP
SSM_STATE = 64
DILATIONS = ((128, 1), (512, 4), (2048, 16))
MAX_WINDOW = 2048
Q_BLOCK = 128
ROPE_THETA = 500000.0
ROT_DIM = HEAD_DIM // 4
D_FF = ((8 * D_MODEL // 3 + 127) // 128) * 128
CONV_W = 3
EPS = 1e-6
IN_WIDTH = 2 * A_WIDTH + B_WIDTH + 3 * C_WIDTH
NEG_INF = -1e30

kernel_name = 'hymba_sgu_s5_dilated_convffn_step'


def rmsnorm(x, g):
    xf = x.astype(jnp.float32)
    y = xf * lax.rsqrt(jnp.mean(xf * xf, -1, keepdims=True) + EPS)
    return (y * g.astype(jnp.float32)).astype(x.dtype)


def rope_partial(x, pos):
    half = ROT_DIM // 2
    inv = ROPE_THETA ** (-(jnp.arange(half, dtype=jnp.float32) * 2.0 / ROT_DIM))
    ang = pos.astype(jnp.float32)[:, None] * inv[None, :]
    cos = jnp.cos(ang)[None, :, None, :]
    sin = jnp.sin(ang)[None, :, None, :]
    xr = x[..., :ROT_DIM].astype(jnp.float32)
    x1, x2 = xr[..., :half], xr[..., half:]
    rot = jnp.concatenate([x1 * cos - x2 * sin, x2 * cos + x1 * sin], -1)
    return jnp.concatenate([rot.astype(x.dtype), x[..., ROT_DIM:]], -1)


def sgu_mixer(uv, w_s, b_s):
    bsz, s, _ = uv.shape
    h = jax.nn.gelu(uv)
    u, v = h[..., :A_WIDTH], h[..., A_WIDTH:]
    vf = v.astype(jnp.float32)
    mu = jnp.mean(vf, -1, keepdims=True)
    var = jnp.mean(jnp.square(vf - mu), -1, keepdims=True)
    vn = ((vf - mu) * lax.rsqrt(var + EPS)).astype(uv.dtype)
    L = min(s, CHUNK)
    nc = s // L
    mask = jnp.tril(jnp.ones((L, L), dtype=bool))
    w = jnp.where(mask[None], w_s[:, :L, :L], 0.0)
    vh = vn.reshape(bsz, nc, L, A_HEADS, HEAD_DIM)
    mixed = jnp.einsum('hij,bcjhd->bcihd', w, vh) + jnp.transpose(b_s[:, :L])[None, None, :, :, None]
    return u * mixed.reshape(bsz, s, A_WIDTH), vn


def s5_mixer(u, h0_re, h0_im, lam_re, lam_im, log_dt, b_re, b_im, c_re, c_im, d_skip, w_glu, b_glu):
    bsz, s, _ = u.shape
    f32 = jnp.float32
    dt = jnp.exp(log_dt.astype(f32))[:, None]
    lr, li = lam_re.astype(f32), lam_im.astype(f32)
    mag = jnp.exp(lr * dt)
    ar, ai = mag * jnp.cos(li * dt), mag * jnp.sin(li * dt)
    nr, ni = ar - 1.0, ai
    den = lr * lr + li * li
    fr, fi = (nr * lr + ni * li) / den, (ni * lr - nr * li) / den
    br, bi = b_re.astype(f32), b_im.astype(f32)
    bbr = fr[..., None] * br - fi[..., None] * bi
    bbi = fr[..., None] * bi + fi[..., None] * br
    ug = u.astype(f32).reshape(bsz, s, B_GROUPS, SSM_GROUP)
    xr = jnp.einsum('bsgc,gpc->bsgp', ug, bbr)
    xi = jnp.einsum('bsgc,gpc->bsgp', ug, bbi)
    h0r, h0i = h0_re.astype(f32), h0_im.astype(f32)
    xr = xr.at[:, 0].add(ar * h0r - ai * h0i)
    xi = xi.at[:, 0].add(ar * h0i + ai * h0r)
    a_r = jnp.broadcast_to(ar[None, None], (1, s, B_GROUPS, SSM_STATE))
    a_i = jnp.broadcast_to(ai[None, None], (1, s, B_GROUPS, SSM_STATE))

    def combine(e1, e2):
        a1r, a1i, b1r, b1i = e1
        a2r, a2i, b2r, b2i = e2
        return (a1r * a2r - a1i * a2i, a1r * a2i + a1i * a2r,
                a2r * b1r - a2i * b1i + b2r, a2r * b1i + a2i * b1r + b2i)

    _, _, hr, hi = lax.associative_scan(combine, (a_r, a_i, xr, xi), axis=1)
    y = (jnp.einsum('bsgp,gcp->bsgc', hr, c_re.astype(f32))
         - jnp.einsum('bsgp,gcp->bsgc', hi, c_im.astype(f32)))
    y = y.reshape(bsz, s, B_WIDTH) + d_skip.astype(f32) * u.astype(f32)
    g = jax.nn.gelu(y).astype(u.dtype)
    out = g * jax.nn.sigmoid(g @ w_glu + b_glu)
    return out, hr[:, -1], hi[:, -1]


def dilated_attention(q, k_src, v_src, q_pos, src_base):
    qf = q.astype(jnp.float32) * (HEAD_DIM ** -0.5)
    lses, outs = [], []
    for window, dil in DILATIONS:
        n_keys = window // dil + 1
        key_pos = q_pos[:, None] - dil * jnp.arange(n_keys)[None, :]
        valid = key_pos >= 0
        idx = jnp.clip(key_pos - src_base, 0, k_src.shape[1] - 1)
        kg = jnp.take(k_src, idx, axis=1).astype(jnp.float32)
        vg = jnp.take(v_src, idx, axis=1).astype(jnp.float32)
        sc = jnp.einsum('bqhd,bqjhd->bqhj', qf, kg)
        sc = jnp.where(valid[None, :, None, :], sc, NEG_INF)
        m = jnp.max(sc, -1, keepdims=True)
        p = jnp.exp(sc - m)
        l = jnp.sum(p, -1, keepdims=True)
        outs.append(jnp.einsum('bqhj,bqjhd->bqhd', p, vg) / l)
        lses.append((m + jnp.log(l))[..., 0])
    alpha = jax.nn.softmax(jnp.stack(lses, 0), axis=0)
    return jnp.sum(alpha[..., None] * jnp.stack(outs, 0), 0)


def attend_prompt(q, k, v):
    bsz, s = q.shape[:2]
    nb = s // Q_BLOCK
    qb = jnp.transpose(q.reshape(bsz, nb, Q_BLOCK, C_HEADS, HEAD_DIM), (1, 0, 2, 3, 4))

    def one(args):
        blk, qblk = args
        pos = blk * Q_BLOCK + jnp.arange(Q_BLOCK)
        return dilated_attention(qblk, k, v, pos, 0).astype(q.dtype)

    out = lax.map(one, (jnp.arange(nb), qb))
    return jnp.transpose(out, (1, 0, 2, 3, 4)).reshape(bsz, s, C_WIDTH)


def attend_sample(k_cache, v_cache, q, k, v):
    bsz, s = q.shape[:2]
    cw = k_cache.shape[1]
    k_src = jnp.concatenate([k_cache, k], 1)
    v_src = jnp.concatenate([v_cache, v], 1)
    pos = PAST_LEN + jnp.arange(s)
    out = dilated_attention(q, k_src, v_src, pos, PAST_LEN - cw)
    return out.astype(q.dtype).reshape(bsz, s, C_WIDTH)


def conv_ffn(x, buf, w_up, conv_w, conv_b, w_down):
    s = x.shape[1]
    h = x @ w_up
    hp = jnp.concatenate([buf.astype(h.dtype), h], 1)
    hc = conv_b + sum(hp[:, j:j + s] * conv_w[j] for j in range(CONV_W))
    g, u = hc[..., :D_FF], hc[..., D_FF:]
    return (jax.nn.gelu(g) * u) @ w_down, hp[:, -(CONV_W - 1):]


def trunk_layer(x, pos, attend, h0_re, h0_im, conv_buf, n1, w_in, w_s, b_s, lam_re, lam_im, log_dt,
                b_re, b_im, c_re, c_im, d_skip, w_glu, b_glu, w_out, n2, w_up, conv_w, conv_b, w_down):
    bsz, s, _ = x.shape
    proj = rmsnorm(x, n1) @ w_in
    o0 = 2 * A_WIDTH
    o1 = o0 + B_WIDTH
    o2 = o1 + C_WIDTH
    o3 = o2 + C_WIDTH
    out_a, v_rows = sgu_mixer(proj[..., :o0], w_s, b_s)
    out_b, h_re, h_im = s5_mixer(proj[..., o0:o1], h0_re, h0_im, lam_re, lam_im, log_dt,
                                 b_re, b_im, c_re, c_im, d_skip, w_glu, b_glu)
    q = rope_partial(proj[..., o1:o2].reshape(bsz, s, C_HEADS, HEAD_DIM), pos)
    k = rope_partial(proj[..., o2:o3].reshape(bsz, s, C_HEADS, HEAD_DIM), pos)
    v = proj[..., o3:].reshape(bsz, s, C_HEADS, HEAD_DIM)
    out_c = attend(q, k, v)
    x = x + jnp.concatenate([out_a, out_b, out_c], -1) @ w_out
    f, conv_new = conv_ffn(rmsnorm(x, n2), conv_buf, w_up, conv_w, conv_b, w_down)
    return x + f, k, v, v_rows, h_re, h_im, conv_new


def setup_inputs(seed: int = 0) -> dict:
    key = jax.random.key(seed)
    ks = jax.random.split(key, 32)
    f32 = jnp.float32

    def nrm(k, shape, scale):
        return scale * jax.random.normal(k, shape, f32)

    cw = min(MAX_WINDOW, PAST_LEN)
    G, P = B_GROUPS, SSM_STATE
    return {
        'x_prompt': nrm(ks[0], (BATCH, SEQ, D_MODEL), 1.0),
        'x_sample': nrm(ks[1], (DEC_BATCH, DEC_SEQ, D_MODEL), 1.0),
        'cache_c_k': nrm(ks[2], (DEPTH, DEC_BATCH, cw, C_HEADS, HEAD_DIM), 1.0),
        'cache_c_v': nrm(ks[3], (DEPTH, DEC_BATCH, cw, C_HEADS, HEAD_DIM), 1.0),
        'state_ssm_re': nrm(ks[4], (DEPTH, DEC_BATCH, G, P), 0.1),
        'state_ssm_im': nrm(ks[5], (DEPTH, DEC_BATCH, G, P), 0.1),
        'state_ffn_conv': nrm(ks[6], (DEPTH, DEC_BATCH, CONV_W - 1, 2 * D_FF), 1.0),
        'norm1_g': 1.0 + nrm(ks[7], (DEPTH, D_MODEL), 0.02),
        'w_in': nrm(ks[8], (DEPTH, D_MODEL, IN_WIDTH), D_MODEL ** -0.5),
        'w_s': nrm(ks[9], (DEPTH, A_HEADS, CHUNK, CHUNK), CHUNK ** -0.5),
        'b_s': 1.0 + nrm(ks[10], (DEPTH, A_HEADS, CHUNK), 0.1),
        'ssm_lam_re': -0.5 + nrm(ks[11], (DEPTH, G, P), 0.01),
        'ssm_lam_im': jnp.pi * jnp.arange(P, dtype=f32) + nrm(ks[12], (DEPTH, G, P), 0.01),
        'ssm_log_dt': jax.random.uniform(ks[13], (DEPTH, G), f32, math.log(1e-3), math.log(1e-1)),
        'ssm_b_re': nrm(ks[14], (DEPTH, G, P, SSM_GROUP), (2 * SSM_GROUP) ** -0.5),
        'ssm_b_im': nrm(ks[15], (DEPTH, G, P, SSM_GROUP), (2 * SSM_GROUP) ** -0.5),
        'ssm_c_re': nrm(ks[16], (DEPTH, G, SSM_GROUP, P), SSM_STATE ** -0.5),
        'ssm_c_im': nrm(ks[17], (DEPTH, G, SSM_GROUP, P), SSM_STATE ** -0.5),
        'ssm_d': nrm(ks[18], (DEPTH, B_WIDTH), 1.0),
        'w_glu': nrm(ks[19], (DEPTH, B_WIDTH, B_WIDTH), B_WIDTH ** -0.5),
        'b_glu': nrm(ks[20], (DEPTH, B_WIDTH), 0.01),
        'w_out': nrm(ks[21], (DEPTH, MIX_WIDTH, D_MODEL), MIX_WIDTH ** -0.5),
        'norm2_g': 1.0 + nrm(ks[22], (DEPTH, D_MODEL), 0.02),
        'w_up': nrm(ks[23], (DEPTH, D_MODEL, 2 * D_FF), D_MODEL ** -0.5),
        'conv_w': nrm(ks[24], (DEPTH, CONV_W, 2 * D_FF), CONV_W ** -0.5),
        'conv_b': nrm(ks[25], (DEPTH, 2 * D_FF), 0.01),
        'w_down': nrm(ks[26], (DEPTH, D_FF, D_MODEL), D_FF ** -0.5),
        'final_g': 1.0 + nrm(ks[27], (D_MODEL,), 0.02),
    }


def reference(x_prompt, x_sample, cache_c_k, cache_c_v, state_ssm_re, state_ssm_im, state_ffn_conv,
              norm1_g, w_in, w_s, b_s, ssm_lam_re, ssm_lam_im, ssm_log_dt, ssm_b_re, ssm_b_im,
              ssm_c_re, ssm_c_im, ssm_d, w_glu, b_glu, w_out, norm2_g, w_up, conv_w, conv_b, w_down,
              final_g):
    bp, sp = x_prompt.shape[:2]
    pos_p = jnp.arange(sp)
    pos_s = PAST_LEN + jnp.arange(x_sample.shape[1])
    cw_p = min(MAX_WINDOW, sp)
    hp, hs = x_prompt, x_sample
    kp_l, vp_l, ks_l, vs_l = [], [], [], []
    srp_l, sip_l, srs_l, sis_l = [], [], [], []
    cvp_l, cvs_l, vsg_l = [], [], []
    for l in range(DEPTH):
        lw = (norm1_g[l], w_in[l], w_s[l], b_s[l], ssm_lam_re[l], ssm_lam_im[l], ssm_log_dt[l],
              ssm_b_re[l], ssm_b_im[l], ssm_c_re[l], ssm_c_im[l], ssm_d[l], w_glu[l], b_glu[l],
              w_out[l], norm2_g[l], w_up[l], conv_w[l], conv_b[l], w_down[l])
        z = jnp.zeros((bp, B_GROUPS, SSM_STATE), jnp.float32)
        zc = jnp.zeros((bp, CONV_W - 1, 2 * D_FF), hp.dtype)
        hp, kp, vp, _, hrp, hip, cnp = trunk_layer(hp, pos_p, attend_prompt, z, z, zc, *lw)
        kp_l.append(kp[:, sp - cw_p:])
        vp_l.append(vp[:, sp - cw_p:])
        srp_l.append(hrp)
        sip_l.append(hip)
        cvp_l.append(cnp)
        att_s = functools.partial(attend_sample, cache_c_k[l], cache_c_v[l])
        hs, kn, vn, vsg, hrs, his, cns = trunk_layer(hs, pos_s, att_s, state_ssm_re[l], state_ssm_im[l],
                                                      state_ffn_conv[l], *lw)
        ks_l.append(kn)
        vs_l.append(vn)
        srs_l.append(hrs)
        sis_l.append(his)
        cvs_l.append(cns)
        vsg_l.append(vsg)
    y_prompt = rmsnorm(hp, final_g)
    y_sample = rmsnorm(hs, final_g)
    return (y_prompt, y_sample,
            jnp.stack(kp_l), jnp.stack(vp_l), jnp.stack(ks_l), jnp.stack(vs_l),
            jnp.stack(srp_l), jnp.stack(sip_l), jnp.stack(srs_l), jnp.stack(sis_l),
            jnp.stack(cvp_l), jnp.stack(cvs_l), jnp.stack(vsg_l))
```

```cpp
#include <hip/hip_runtime.h>
#include <cstdio>
#include <cstdint>

namespace pg8 {
#define PG8_LAS __attribute__((address_space(3)))
typedef unsigned short bf16_t;
typedef short bf16x8 __attribute__((ext_vector_type(8)));
typedef float f32x4 __attribute__((ext_vector_type(4)));
typedef unsigned u32x4 __attribute__((ext_vector_type(4)));
constexpr int BM = 256, BK = 64, HALF = 128, HTB = HALF * BK * 2  , STAGE_BYTES = 8 * HTB, NXCD = 8, WGM = 8;

__host__ __device__ __forceinline__ int lds_byte(int r, int c) { const int st = (r >> 4) * 2 + (c >> 5), rr = r & 15, cc = c & 31, ob = rr * 64 + cc * 2; return st * 1024 + (ob ^ (((ob >> 9) & 1) << 5)); }
__host__ __device__ __forceinline__ void stage_rc(int b, int& R, int& C) { const int st = b / 1024, sb = b % 1024, swz = sb ^ (((sb >> 9) & 1) << 5); R = (st >> 1) * 16 + swz / 64; C = (st & 1) * 32 + (swz % 64) / 2; }
__host__ __device__ __forceinline__ int perm32(int rho) { const int n = rho >> 4, i = rho & 15; return 8 * (i >> 2) + 4 * n + (i & 3); }

struct Unit { int pm, pn; };
struct Gemm { const bf16_t* A; const bf16_t* Bt; int M, N, K; };

struct StaticOrder {
    int nM, nN, nwg, G, c;
    __host__ __device__ void init(int M, int N, int G_, int c_) { nM = M / BM; nN = N / BM; nwg = nM * nN; G = G_; c = c_; }
    __host__ __device__ bool next(int i, Unit& u) const {
        const long L = (long)i * G + c; if (L >= nwg) return false;
        int wgid = (int)L; { const int q = nwg / NXCD, r = nwg % NXCD, xcd = wgid % NXCD, off = wgid / NXCD; wgid = (xcd < r ? xcd * (q + 1) : r * (q + 1) + (xcd - r) * q) + off; }
        const int nig = WGM * nN, gid = wgid / nig, fm = gid * WGM, gsz = (nM - fm) < WGM ? (nM - fm) : WGM;
        u.pm = fm + ((wgid % nig) % gsz); u.pn = (wgid % nig) / gsz; return true;
    }
    __device__ __forceinline__ void a_ready(const Unit&) const {}
    __device__ __forceinline__ void done(const Unit&) const {}
};

__device__ __forceinline__ unsigned cvt_pk_bf16(float lo, float hi) { unsigned r; asm volatile("v_cvt_pk_bf16_f32 %0, %1, %2" : "=v"(r) : "v"(lo), "v"(hi)); return r; }
typedef float f32x2 __attribute__((ext_vector_type(2)));
__device__ __forceinline__ f32x2 gelu_pk(f32x2 v) {
    const f32x2 av = __builtin_elementwise_abs(v), d = av * 0.2316418882f + 1.0f;
    f32x2 t; t.x = __builtin_amdgcn_rcpf(d.x); t.y = __builtin_amdgcn_rcpf(d.y);
    f32x2 q = t * 0.5307027145f + (-0.7265760135f); q = q * t + 0.7107068705f; q = q * t + (-0.142248368f); q = q * t + 0.127414796f; q = q * t;
    const f32x2 s = (v * v) * (-0.72134752044f);
    f32x2 e; e.x = __builtin_amdgcn_exp2f(s.x); e.y = __builtin_amdgcn_exp2f(s.y);
    const f32x2 m = v * (q * e), r = v - m;
    f32x2 o; o.x = v.x < 0.f ? m.x : r.x; o.y = v.y < 0.f ? m.y : r.y; return o;
}

template <class Epi, class Sched, bool ALIGN_EPI = false, bool SP2 = false>
__device__ __forceinline__ void gemm_phase(PG8_LAS unsigned char* lds, const Gemm g, const Sched& S, const Epi& E, const int wid_in) {
    int lane_ = (int)__builtin_amdgcn_mbcnt_hi(~0u, __builtin_amdgcn_mbcnt_lo(~0u, 0u)); asm volatile("" : "+v"(lane_));
    const int wid = wid_in, lane = lane_, tid = wid * 64 + lane, wr = wid >> 2, wc = wid & 3, fr = lane & 15, fq = lane >> 4;
    const int K = g.K, nt = K / BK;
    unsigned voffA[2], voffB[2];
#pragma unroll
    for (int i = 0; i < 2; ++i) { int R, C; stage_rc(tid * 16 + i * 8192, R, C); const int Rb = Epi::PERM ? ((R & ~31) + perm32(R & 31)) : R;
        voffA[i] = (unsigned)(R * K + C) * 2u; voffB[i] = (unsigned)(Rb * K + C) * 2u; }
    const size_t kstep = (size_t)(BK * 2);
    const size_t hstep = (size_t)HALF * K * 2;
    const size_t tstep = 2 * hstep;
    const unsigned ldsw = (unsigned)wid * 1024u;
    const int aoff = lds_byte(wr * 64 + fr, fq * 8), boff = lds_byte(wc * 32 + fr, fq * 8);
#define PG8_SA(b, h) (((b) * 2 + (h)) * HTB)
#define PG8_SB(b, h) ((4 + (b) * 2 + (h)) * HTB)
#define PG8_STAGE(bufoff, gbase, voff) do { _Pragma("unroll") for (int _i = 0; _i < 2; ++_i) \
        __builtin_amdgcn_global_load_lds((const unsigned*)((const char*)(gbase) + (voff)[_i]), (PG8_LAS unsigned*)(lds + (bufoff) + ldsw + _i * 8192), 16, 0, 0); } while (0)
#define PG8_LDA(dst, b, h) do { _Pragma("unroll") for (int m = 0; m < 4; ++m) _Pragma("unroll") for (int k = 0; k < 2; ++k) dst[m][k] = *(const PG8_LAS bf16x8*)(lds + PG8_SA(b, h) + aoff + m * 2048 + k * 1024); } while (0)
#define PG8_LDB(dst, b, h) do { _Pragma("unroll") for (int n = 0; n < 2; ++n) _Pragma("unroll") for (int k = 0; k < 2; ++k) dst[n][k] = *(const PG8_LAS bf16x8*)(lds + PG8_SB(b, h) + boff + n * 2048 + k * 1024); } while (0)
#define PG8_MMA(ai, bj, At, Bt) do { __builtin_amdgcn_s_setprio(1); _Pragma("unroll") for (int m = 0; m < 4; ++m) _Pragma("unroll") for (int n = 0; n < 2; ++n) _Pragma("unroll") for (int k = 0; k < 2; ++k) \
        acc[ai][bj][m][n] = __builtin_amdgcn_mfma_f32_16x16x32_bf16(Bt[n][k], At[m][k], acc[ai][bj][m][n], 0, 0, 0); __builtin_amdgcn_s_setprio(0); } while (0)
#define PG8_WAIT_V(n) asm volatile("s_waitcnt vmcnt(" #n ")" ::: "memory")
#define PG8_WAIT_L(n) asm volatile("s_waitcnt lgkmcnt(" #n ")" ::: "memory")
#define PG8_BAR __builtin_amdgcn_s_barrier()
#define PG8_SCHED __builtin_amdgcn_sched_barrier(0)
    Unit cur, nxt; int ui = 0;
    if (!S.next(0, cur)) return;
    f32x4 acc[2][2][4][2];
#pragma unroll
    for (int a = 0; a < 2; ++a)
#pragma unroll
        for (int b = 0; b < 2; ++b)
#pragma unroll
            for (int m = 0; m < 4; ++m)
#pragma unroll
                for (int n = 0; n < 2; ++n) acc[a][b][m][n] = (f32x4){0.f, 0.f, 0.f, 0.f};
    bf16x8 At[4][2], B0[2][2], B1[2][2];
    const char* cA = (const char*)g.A + (size_t)cur.pm * tstep; const char* cB = (const char*)g.Bt + (size_t)cur.pn * tstep;
    S.a_ready(cur);
    if constexpr (SP2) {
        PG8_STAGE(PG8_SB(0, 0), cB, voffB); PG8_STAGE(PG8_SB(0, 1), cB + hstep, voffB); PG8_STAGE(PG8_SA(0, 0), cA, voffA); PG8_STAGE(PG8_SA(0, 1), cA + hstep, voffA);
        if (wr == 1) PG8_BAR;
        PG8_WAIT_V(2); PG8_BAR;
        PG8_STAGE(PG8_SB(1, 0), cB + kstep, voffB); PG8_STAGE(PG8_SA(1, 0), cA + kstep, voffA); PG8_STAGE(PG8_SB(1, 1), cB + hstep + kstep, voffB);
        PG8_WAIT_V(6); PG8_BAR;
    } else {
        PG8_STAGE(PG8_SB(0, 0), cB, voffB); PG8_STAGE(PG8_SA(0, 0), cA, voffA); PG8_STAGE(PG8_SB(0, 1), cB + hstep, voffB); PG8_STAGE(PG8_SA(0, 1), cA + hstep, voffA);
        if (wr == 1) PG8_BAR;
        PG8_WAIT_V(4); PG8_BAR;
        PG8_STAGE(PG8_SB(1, 0), cB + kstep, voffB); PG8_STAGE(PG8_SA(1, 0), cA + kstep, voffA); PG8_STAGE(PG8_SB(1, 1), cB + hstep + kstep, voffB);
        PG8_WAIT_V(6); PG8_BAR;
    }
    for (;;) {
        const bool has_next = S.next(ui + 1, nxt);
        const char* nA = has_next ? (const char*)g.A + (size_t)nxt.pm * tstep : cA; const char* nB = has_next ? (const char*)g.Bt + (size_t)nxt.pn * tstep : cB;
        for (int t = 0; t < nt; t += 2) {
            const bool last = (t == nt - 2);
            const char* a1 = cA + (size_t)(t + 1) * kstep;
            const char* a2 = last ? nA : cA + (size_t)(t + 2) * kstep; const char* b2 = last ? nB : cB + (size_t)(t + 2) * kstep;
            const char* a3 = a2 + kstep; const char* b3 = b2 + kstep;
            if (last && has_next) S.a_ready(nxt);
            if constexpr (SP2) {
            PG8_LDB(B0, 0, 0); PG8_LDB(B1, 0, 1); PG8_SCHED; PG8_LDA(At, 0, 0); PG8_STAGE(PG8_SA(1, 1), a1 + hstep, voffA);
            PG8_WAIT_V(8); PG8_WAIT_L(0); PG8_BAR; PG8_MMA(0, 0, At, B0); PG8_MMA(0, 1, At, B1); PG8_BAR; PG8_SCHED;
            PG8_LDA(At, 0, 1); PG8_STAGE(PG8_SB(0, 0), b2, voffB); PG8_STAGE(PG8_SB(0, 1), b2 + hstep, voffB); PG8_STAGE(PG8_SA(0, 0), a2, voffA);
            PG8_WAIT_V(8); PG8_WAIT_L(0); PG8_BAR; PG8_MMA(1, 0, At, B0); PG8_MMA(1, 1, At, B1); PG8_BAR; PG8_SCHED;
            PG8_LDB(B0, 1, 0); PG8_LDB(B1, 1, 1); PG8_SCHED; PG8_LDA(At, 1, 0); PG8_STAGE(PG8_SA(0, 1), a2 + hstep, voffA);
            PG8_WAIT_V(8); PG8_WAIT_L(0); PG8_BAR; PG8_MMA(0, 0, At, B0); PG8_MMA(0, 1, At, B1); PG8_BAR; PG8_SCHED;
            PG8_LDA(At, 1, 1); PG8_STAGE(PG8_SB(1, 0), b3, voffB); PG8_STAGE(PG8_SB(1, 1), b3 + hstep, voffB); PG8_STAGE(PG8_SA(1, 0), a3, voffA);
            PG8_WAIT_V(8); PG8_WAIT_L(0); PG8_BAR; PG8_MMA(1, 0, At, B0); PG8_MMA(1, 1, At, B1); PG8_BAR; PG8_SCHED;
            } else {
            PG8_LDB(B0, 0, 0); PG8_SCHED; PG8_LDA(At, 0, 0); PG8_STAGE(PG8_SA(1, 1), a1 + hstep, voffA);
            PG8_WAIT_L(8); PG8_BAR; PG8_WAIT_L(0); PG8_MMA(0, 0, At, B0); PG8_BAR; PG8_SCHED;
            PG8_LDB(B1, 0, 1); PG8_STAGE(PG8_SB(0, 0), b2, voffB);
            PG8_BAR; PG8_WAIT_L(0); PG8_MMA(0, 1, At, B1); PG8_BAR;
            PG8_LDA(At, 0, 1); PG8_STAGE(PG8_SA(0, 0), a2, voffA);
            PG8_BAR; PG8_WAIT_L(0); PG8_MMA(1, 0, At, B0); PG8_BAR; PG8_SCHED;
            PG8_STAGE(PG8_SB(0, 1), b2 + hstep, voffB);
            PG8_WAIT_V(6); PG8_BAR; PG8_MMA(1, 1, At, B1); PG8_BAR;
            PG8_LDB(B0, 1, 0); PG8_SCHED; PG8_LDA(At, 1, 0); PG8_STAGE(PG8_SA(0, 1), a2 + hstep, voffA);
            PG8_WAIT_L(8); PG8_BAR; PG8_WAIT_L(0); PG8_MMA(0, 0, At, B0); PG8_BAR; PG8_SCHED;
            PG8_LDB(B1, 1, 1); PG8_STAGE(PG8_SB(1, 0), b3, voffB);
            PG8_BAR; PG8_WAIT_L(0); PG8_MMA(0, 1, At, B1); PG8_BAR;
            PG8_LDA(At, 1, 1); PG8_STAGE(PG8_SA(1, 0), a3, voffA);
            PG8_BAR; PG8_WAIT_L(0); PG8_MMA(1, 0, At, B0); PG8_BAR; PG8_SCHED;
            PG8_STAGE(PG8_SB(1, 1), b3 + hstep, voffB);
            PG8_WAIT_V(6); PG8_BAR; PG8_MMA(1, 1, At, B1); PG8_BAR;
            }
        }
        if constexpr (ALIGN_EPI) { if (wr == 0) PG8_BAR; }
        if constexpr (!Epi::AFTER_DRAIN) { E(acc, cur, wr, wc, fr, fq); S.done(cur); }
        if (!has_next) break;
#pragma unroll
        for (int a = 0; a < 2; ++a)
#pragma unroll
            for (int b = 0; b < 2; ++b)
#pragma unroll
                for (int m = 0; m < 4; ++m)
#pragma unroll
                    for (int n = 0; n < 2; ++n) acc[a][b][m][n] = (f32x4){0.f, 0.f, 0.f, 0.f};
        cur = nxt; cA = nA; cB = nB; ++ui;
        if constexpr (ALIGN_EPI) { if (wr == 1) PG8_BAR; }
    }
    PG8_WAIT_V(0);
    if constexpr (!ALIGN_EPI) { if (wr == 0) PG8_BAR; }
    PG8_BAR;
    if constexpr (Epi::AFTER_DRAIN) { E.fused(acc, cur, wr, wc, fr, fq, lds, wid, lane); S.done(cur); }
#undef PG8_SA
#undef PG8_SB
#undef PG8_STAGE
#undef PG8_LDA
#undef PG8_LDB
#undef PG8_MMA
#undef PG8_WAIT_V
#undef PG8_WAIT_L
#undef PG8_BAR
#undef PG8_SCHED
}
}
#define GAS __attribute__((address_space(1)))
#define LAS __attribute__((address_space(3)))
typedef unsigned short bf16;
typedef unsigned v4u __attribute__((ext_vector_type(4)));
typedef float f32x4 __attribute__((ext_vector_type(4)));
typedef short bf16x8 __attribute__((ext_vector_type(8)));
typedef GAS unsigned gu32;
typedef GAS unsigned long long gu64;
#define RLX_AGENT __ATOMIC_RELAXED, __HIP_MEMORY_SCOPE_AGENT
#define LDS_WAIT() asm volatile("s_waitcnt lgkmcnt(0)" ::: "memory")
#define VM_WAIT() asm volatile("s_waitcnt vmcnt(0)" ::: "memory")
__device__ __forceinline__ unsigned long long rt() { return __builtin_amdgcn_s_memrealtime(); }
__device__ __forceinline__ unsigned f2bf(float f) { unsigned u = __builtin_bit_cast(unsigned, f); return (u + 0x7fffu + ((u >> 16) & 1u)) >> 16; }
__device__ __forceinline__ unsigned pk2(float lo, float hi) { return f2bf(lo) | (f2bf(hi) << 16); }

#define XB_TMO      128
#define XB_XCNT(j)  (256  + 64 * (j))
#define XB_XSUB(j)  (1280 + 64 * (j))
#define XB_XGEN(j)  (2304 + 64 * (j))
#define XB_TOP      3328
#define XB_TOPGEN   3392
#define XCD_BAR_WORDS 3456
#define XB_SPIN_CAP (1u << 18)

__device__ __forceinline__ unsigned xb_ld(unsigned* p)              { return __hip_atomic_load(p, __ATOMIC_RELAXED, __HIP_MEMORY_SCOPE_AGENT); }
__device__ __forceinline__ unsigned xb_add(unsigned* p, unsigned v) { return __hip_atomic_fetch_add(p, v, __ATOMIC_RELAXED, __HIP_MEMORY_SCOPE_AGENT); }
__device__ __forceinline__ unsigned xb_xcc_id() { return (unsigned)__builtin_amdgcn_s_getreg((3 << 11) | 20) & 0xFu; }
#define XB_SPIN(cond, bar) do { unsigned _sp = 0; while (cond) { __builtin_amdgcn_s_sleep(1); \
    if ((++_sp & 255u) == 0u) { if (xb_ld(&(bar)[XB_TMO])) break; if (_sp > XB_SPIN_CAP) { atomicAdd(&(bar)[XB_TMO], 1u); break; } } } } while (0)

struct XcdBarrier {
    unsigned* bar; unsigned x;
    volatile LAS unsigned* st;
};

__device__ __forceinline__ XcdBarrier xcd_barrier_post(unsigned* bar, volatile LAS unsigned* st) {
    XcdBarrier b; b.bar = bar; b.x = xb_xcc_id(); b.st = st;
    if (threadIdx.x == 0) (void)xb_add(&bar[XB_XCNT(b.x)], 1u);
    return b;
}
__device__ __forceinline__ void xcd_barrier_complete(unsigned* bar, unsigned x, unsigned& nloc, unsigned& nx) {
    const unsigned G = gridDim.x * gridDim.y * gridDim.z;
    unsigned sum, cnt, mine, sp = 0u;
    for (;;) {
        sum = 0u; cnt = 0u; mine = 0u;
#pragma unroll
        for (unsigned j = 0; j < 16; ++j) { const unsigned c = xb_ld(&bar[XB_XCNT(j)]); sum += c; cnt += (c > 0u) ? 1u : 0u; mine = (j == x) ? c : mine; }
        if (sum == G) break;
        __builtin_amdgcn_s_sleep(1);
        if ((++sp & 255u) == 0u) { if (xb_ld(&bar[XB_TMO])) break; if (sp > XB_SPIN_CAP) { atomicAdd(&bar[XB_TMO], 1u); break; } }
    }
    nloc = mine > 0u ? mine : 1u; nx = cnt > 0u ? cnt : 1u;
}

__device__ __forceinline__ void xcd_barrier(const XcdBarrier& b) {
    asm volatile("s_waitcnt vmcnt(0)" ::: "memory");
    __syncthreads();
    if (threadIdx.x == 0) {
        unsigned* bar = b.bar;
        __builtin_amdgcn_s_waitcnt(0);
        unsigned nloc = b.st[0], nx = b.st[1];
        if (nloc == 0u) { xcd_barrier_complete(bar, b.x, nloc, nx); b.st[0] = nloc; b.st[1] = nx; }
        const unsigned old = xb_add(&bar[XB_XSUB(b.x)], 1u);
        const unsigned gen = old / nloc;
        if (old + 1u == (gen + 1u) * nloc) {
            __builtin_amdgcn_fence(__ATOMIC_RELEASE, "agent");
            asm volatile("s_waitcnt vmcnt(0)" ::: "memory");
            const unsigned og = xb_add(&bar[XB_TOP], 1u);
            const unsigned tg = og / nx;
            if (og + 1u == (tg + 1u) * nx) xb_add(&bar[XB_TOPGEN], 1u);
            else XB_SPIN(xb_ld(&bar[XB_TOPGEN]) == tg, bar);
            __builtin_amdgcn_fence(__ATOMIC_ACQUIRE, "agent");
            xb_add(&bar[XB_XGEN(b.x)], 1u);
            asm volatile("s_waitcnt vmcnt(0)" ::: "memory");
        } else {
            XB_SPIN(xb_ld(&bar[XB_XGEN(b.x)]) == gen, bar);
            __builtin_amdgcn_fence(__ATOMIC_ACQUIRE, "agent");
            asm volatile("s_waitcnt vmcnt(0)" ::: "memory");
        }
    }
    __syncthreads();
}

#define DI __device__ __forceinline__
typedef short s16x4 __attribute__((ext_vector_type(4)));
typedef float f32x16 __attribute__((ext_vector_type(16)));
typedef float f32x2 __attribute__((ext_vector_type(2)));
typedef unsigned u32x2 __attribute__((ext_vector_type(2)));
typedef unsigned u32x4 __attribute__((ext_vector_type(4)));
typedef __bf16 bf16x2_t __attribute__((ext_vector_type(2)));

constexpr int DM = 1024, NBATCH = 2, SEQ = 8192, DEPTH = 4, SBATCH = 32, STOK = 8, PAST = 8192;
constexpr int MP = NBATCH * SEQ, MS = SBATCH * STOK, MR = MP + MS;
constexpr int AW = 256, BW = 384, CWD = 384, AH = 4, CH = 6, HD = 64;
constexpr int NG = 24, NP = 64;
constexpr int DFF = 2816, DFF2 = 5632, INW = 2048;
constexpr int O_U = 0, O_V = 256, O_S5 = 512, O_Q = 896, O_K = 1280, O_VV = 1664;
constexpr int CWIN = 2048;
constexpr float EPSN = 1e-6f;
constexpr int NWAVES = 8, NTHR = 512;

constexpr size_t OUT_YP = 0;
constexpr size_t OUT_YS = OUT_YP + (size_t)MP * DM;
constexpr size_t OUT_KP = OUT_YS + (size_t)MS * DM;
constexpr size_t OUT_VP = OUT_KP + (size_t)DEPTH * NBATCH * CWIN * CWD;
constexpr size_t OUT_KS = OUT_VP + (size_t)DEPTH * NBATCH * CWIN * CWD;
constexpr size_t OUT_VS = OUT_KS + (size_t)DEPTH * SBATCH * STOK * CWD;
constexpr size_t OUT_SRP = OUT_VS + (size_t)DEPTH * SBATCH * STOK * CWD;
constexpr size_t OUT_SIP = OUT_SRP + (size_t)DEPTH * NBATCH * NG * NP;
constexpr size_t OUT_SRS = OUT_SIP + (size_t)DEPTH * NBATCH * NG * NP;
constexpr size_t OUT_SIS = OUT_SRS + (size_t)DEPTH * SBATCH * NG * NP;
constexpr size_t OUT_FCP = OUT_SIS + (size_t)DEPTH * SBATCH * NG * NP;
constexpr size_t OUT_FCS = OUT_FCP + (size_t)DEPTH * NBATCH * 2 * DFF2;
constexpr size_t OUT_SGV = OUT_FCS + (size_t)DEPTH * SBATCH * 2 * DFF2;
constexpr size_t OUT_END = OUT_SGV + (size_t)DEPTH * SBATCH * STOK * AW;

constexpr size_t MiB = 1u << 20;
constexpr size_t WS_CTL = 0, CTL_ZERO_BYTES = 1 * MiB;
constexpr size_t WS_ROPE = 1 * MiB;
constexpr size_t WS_S5P = 2 * MiB, S5P_STRIDE = 256 * 1024;
constexpr size_t S5P_BMAT = 0, S5P_CMAT = 98304, S5P_A = 196608;
constexpr size_t WS_WSM = 3 * MiB;
constexpr size_t WS_WGLU = 4 * MiB, WGLU_STRIDE = 384 * 384 * 2;
constexpr size_t WS_RSS = 6 * MiB;
constexpr size_t WS_S5L = 8 * MiB;
constexpr size_t WS_LSE = 14 * MiB;
constexpr size_t WS_W = 16 * MiB, W_STRIDE = 23592960;
constexpr size_t W_IN = 0, W_OUT = 4 * MiB, W_UP = 6 * MiB, W_DOWN = 17 * MiB;
constexpr size_t WS_X = 106 * MiB;
constexpr size_t WS_XB = 171 * MiB;
constexpr size_t WS_PROJ = 204 * MiB;
constexpr size_t WS_MIX = 269 * MiB;
constexpr size_t WS_OP = 302 * MiB;
constexpr size_t WS_HB = 338 * MiB;
constexpr size_t WS_A2 = 517 * MiB;
constexpr size_t WS_END = 607 * MiB;
static_assert(W_STRIDE == 4 * MiB + 2 * MiB + 11 * MiB + 5 * MiB + MiB / 2, "weights");
static_assert(WS_W + 4 * W_STRIDE <= WS_X && WS_X + (size_t)MR * DM * 4 <= WS_XB && WS_XB + (size_t)MR * DM * 2 <= WS_PROJ && WS_PROJ + (size_t)MR * INW * 2 <= WS_MIX &&
              WS_MIX + (size_t)MR * DM * 2 <= WS_OP && WS_OP + (size_t)3 * MP * CWD * 2 <= WS_HB && WS_HB + (size_t)MR * DFF2 * 2 <= WS_A2 && WS_A2 + (size_t)MR * DFF * 2 <= WS_END, "ws map");
static_assert(WS_S5L + (size_t)64 * 4 * 2 * 24 * 64 * 8 <= WS_LSE && WS_LSE + (size_t)3 * MP * 6 * 4 <= WS_W && WS_RSS + (size_t)MR * 16 * 4 <= WS_S5L, "ws map 2");

constexpr int CW_BAR = 4096;

constexpr int RING_BYTES = 131072, LDSCTL_OFF = RING_BYTES, MISC_OFF = LDSCTL_OFF + 320, LDS_BYTES = 147456;

DI float bf2f(unsigned short v) { return __uint_as_float(((unsigned)v) << 16); }
DI unsigned cvtpk(float lo, float hi) { f32x2 v = {lo, hi}; bf16x2_t b = __builtin_convertvector(v, bf16x2_t); return __builtin_bit_cast(unsigned, b); }
DI unsigned short f2bf1(float x) { return (unsigned short)(cvtpk(x, 0.f) & 0xffffu); }
DI float gelu_t(float x) {
    const float z = x * (1.0f + 0.044715f * x * x);
    const float e = __builtin_amdgcn_exp2f(-2.3022081985f * z);
    return x * __builtin_amdgcn_rcpf(1.0f + e);
}
DI float sigmoid_f(float x) { return __builtin_amdgcn_rcpf(1.0f + __builtin_amdgcn_exp2f(-1.4426950409f * x)); }
DI int crow(int reg, int h) { return (reg & 3) + 8 * (reg >> 2) + 4 * h; }
DI f32x16 mfma32(bf16x8 a, bf16x8 b, f32x16 c) { return __builtin_amdgcn_mfma_f32_32x32x16_bf16(a, b, c, 0, 0, 0); }
DI f32x16 zero16() { f32x16 z; for (int i = 0; i < 16; ++i) z[i] = 0.f; return z; }
DI float wave_sum(float v) {
#pragma unroll
    for (int o = 1; o < 64; o <<= 1) v += __shfl_xor(v, o);
    return v;
}
DI float wave_max(float v) {
#pragma unroll
    for (int o = 1; o < 64; o <<= 1) v = fmaxf(v, __shfl_xor(v, o));
    return v;
}
DI int rope_phys(int d) { return d < 8 ? 2 * d : (d < 16 ? 2 * (d - 8) + 1 : d); }
__host__ __device__ inline int rope_log(int p) { return p < 16 ? ((p & 1) ? 8 + (p >> 1) : (p >> 1)) : p; }
DI int row_pos(int row) { return row < MP ? (row & (SEQ - 1)) : PAST + ((row - MP) & (STOK - 1)); }

struct Args { const float* in[28]; float* out; unsigned char* ws; int ph_lo, ph_hi; };
struct Frame {
    LAS unsigned char* lds;
    int tid, lane, wave, G, bid;
    float* out;
    unsigned char* ws;
};
#define FIN(k) (args.in[k])
DI void launder(Frame& F) { asm volatile("" : "+s"(F.bid), "+s"(F.G)); int ln = (int)__builtin_amdgcn_mbcnt_hi(~0u, __builtin_amdgcn_mbcnt_lo(~0u, 0u)); asm volatile("" : "+v"(ln)); F.lane = ln; F.tid = F.wave * 64 + ln; }
DI int launder_i(int x) { asm volatile("" : "+s"(x)); return x; }

DI float row_rstd(const float* rss, int row) {
    const f32x4* rp = (const f32x4*)(rss + (size_t)row * 16);
    const f32x4 a = rp[0], b = rp[1], c = rp[2], d = rp[3];
    const float s = ((a.x + a.y) + (a.z + a.w)) + ((b.x + b.y) + (b.z + b.w)) + ((c.x + c.y) + (c.z + c.w)) + ((d.x + d.y) + (d.z + d.w));
    return 1.0f / sqrtf(s * (1.0f / DM) + EPSN);
}
DI void store8_bf16(bf16* dst, const float (&v)[8]) {
    u32x4 w; w.x = cvtpk(v[0], v[1]); w.y = cvtpk(v[2], v[3]); w.z = cvtpk(v[4], v[5]); w.w = cvtpk(v[6], v[7]);
    *(u32x4*)dst = w;
}

struct EpiIn {
    static constexpr bool PERM = true, AFTER_DRAIN = false;
    bf16* proj; const float* rss; const f32x2* rope; float* out; int layer;
    DI void operator()(const pg8::f32x4 (&acc)[2][2][4][2], const pg8::Unit& u, int wr, int wc, int fr, int fq) const {
#pragma unroll
        for (int ai = 0; ai < 2; ++ai)
#pragma unroll
            for (int m = 0; m < 4; ++m) {
                const int row = u.pm * 256 + ai * 128 + wr * 64 + m * 16 + fr;
                const float rstd = row_rstd(rss, row);
                const int pos = row_pos(row);
#pragma unroll
                for (int bj = 0; bj < 2; ++bj) {
                    const int c0 = u.pn * 256 + bj * 128 + wc * 32 + 8 * fq;
                    float v[8];
#pragma unroll
                    for (int e = 0; e < 4; ++e) { v[e] = acc[ai][bj][m][0][e] * rstd; v[4 + e] = acc[ai][bj][m][1][e] * rstd; }
                    if (c0 < O_S5) {
#pragma unroll
                        for (int e = 0; e < 8; ++e) v[e] = gelu_t(v[e]);
                    } else if (c0 >= O_Q) {
                        const int hd = (c0 - O_Q) & 63, head = ((c0 - O_Q) >> 6) % CH;
                        const bool isk = c0 >= O_K && c0 < O_VV, isv = c0 >= O_VV;
                        if (!isv && hd < 16) {
                            const f32x4* rp = (const f32x4*)(rope + (size_t)pos * 8 + (hd >> 1));
                            const f32x4 t0 = rp[0], t1 = rp[1];
                            const float cs[4] = {t0.x, t0.z, t1.x, t1.z}, sn[4] = {t0.y, t0.w, t1.y, t1.w};
#pragma unroll
                            for (int j = 0; j < 4; ++j) { const float x1 = v[2 * j], x2 = v[2 * j + 1]; v[2 * j] = x1 * cs[j] - x2 * sn[j]; v[2 * j + 1] = x2 * cs[j] + x1 * sn[j]; }
                        }
                        if (isk || isv) {
                            float* dst = nullptr;
                            if (row < MP) { const int b = row >> 13, t = row & (SEQ - 1);
                                if (t >= SEQ - CWIN) dst = out + (isk ? OUT_KP : OUT_VP) + ((((size_t)layer * NBATCH + b) * CWIN + (t - (SEQ - CWIN))) * CH + head) * HD;
                            } else { const int rs = row - MP;
                                dst = out + (isk ? OUT_KS : OUT_VS) + (((size_t)layer * MS + rs) * CH + head) * HD; }
                            if (dst) {
                                if (isk && hd < 16) { *(f32x4*)(dst + (hd >> 1)) = (f32x4){v[0], v[2], v[4], v[6]}; *(f32x4*)(dst + 8 + (hd >> 1)) = (f32x4){v[1], v[3], v[5], v[7]}; }
                                else { *(f32x4*)(dst + hd) = (f32x4){v[0], v[1], v[2], v[3]}; *(f32x4*)(dst + hd + 4) = (f32x4){v[4], v[5], v[6], v[7]}; }
                            }
                        }
                    }
                    store8_bf16(proj + (size_t)row * INW + c0, v);
                }
                asm volatile("" ::: "memory");
            }
    }
};

struct EpiRes {
    static constexpr bool PERM = true, AFTER_DRAIN = false;
    const float* xp; const float* xs; float* X; bf16* XB; float* rss; int first;
    DI void operator()(const pg8::f32x4 (&acc)[2][2][4][2], const pg8::Unit& u, int wr, int wc, int fr, int fq) const {
#pragma unroll
        for (int ai = 0; ai < 2; ++ai)
#pragma unroll
            for (int m = 0; m < 4; ++m) {
                const int row = u.pm * 256 + ai * 128 + wr * 64 + m * 16 + fr;
                const float* src = first ? (row < MP ? xp + (size_t)row * DM : xs + (size_t)(row - MP) * DM) : X + (size_t)row * DM;
                float ss = 0.f;
#pragma unroll
                for (int bj = 0; bj < 2; ++bj) {
                    const int c0 = u.pn * 256 + bj * 128 + wc * 32 + 8 * fq;
                    const f32x4 a0 = *(const f32x4*)(src + c0), a1 = *(const f32x4*)(src + c0 + 4);
                    float v[8];
#pragma unroll
                    for (int e = 0; e < 4; ++e) { v[e] = acc[ai][bj][m][0][e] + a0[e]; v[4 + e] = acc[ai][bj][m][1][e] + a1[e]; }
                    *(f32x4*)(X + (size_t)row * DM + c0) = (f32x4){v[0], v[1], v[2], v[3]};
                    *(f32x4*)(X + (size_t)row * DM + c0 + 4) = (f32x4){v[4], v[5], v[6], v[7]};
                    store8_bf16(XB + (size_t)row * DM + c0, v);
#pragma unroll
                    for (int e = 0; e < 8; ++e) ss += v[e] * v[e];
                }
                ss += __shfl_xor(ss, 16); ss += __shfl_xor(ss, 32);
                if (fq == 0) rss[(size_t)row * 16 + u.pn * 4 + wc] = ss;
                asm volatile("" ::: "memory");
            }
    }
};

struct EpiUp {
    static constexpr bool PERM = true, AFTER_DRAIN = false;
    bf16* hb; const float* rss; float* out; int layer;
    DI void operator()(const pg8::f32x4 (&acc)[2][2][4][2], const pg8::Unit& u, int wr, int wc, int fr, int fq) const {
#pragma unroll
        for (int ai = 0; ai < 2; ++ai)
#pragma unroll
            for (int m = 0; m < 4; ++m) {
                const int row = u.pm * 256 + ai * 128 + wr * 64 + m * 16 + fr;
                const float rstd = row_rstd(rss, row);
                float* sdst = nullptr;
                if (row < MP) { const int b = row >> 13, t = row & (SEQ - 1); if (t >= SEQ - 2) sdst = out + OUT_FCP + (((size_t)layer * NBATCH + b) * 2 + (t - (SEQ - 2))) * DFF2; }
                else { const int rs = row - MP, sb = rs >> 3, t = rs & 7; if (t >= STOK - 2) sdst = out + OUT_FCS + (((size_t)layer * SBATCH + sb) * 2 + (t - (STOK - 2))) * DFF2; }
#pragma unroll
                for (int bj = 0; bj < 2; ++bj) {
                    const int cl = bj * DFF + u.pn * 128 + wc * 32 + 8 * fq;
                    float v[8];
#pragma unroll
                    for (int e = 0; e < 4; ++e) { v[e] = acc[ai][bj][m][0][e] * rstd; v[4 + e] = acc[ai][bj][m][1][e] * rstd; }
                    store8_bf16(hb + (size_t)row * DFF2 + cl, v);
                    if (sdst) { *(f32x4*)(sdst + cl) = (f32x4){v[0], v[1], v[2], v[3]}; *(f32x4*)(sdst + cl + 4) = (f32x4){v[4], v[5], v[6], v[7]}; }
                }
                asm volatile("" ::: "memory");
            }
    }
};

template <int MODE> DI int wrow_map(int n) {
    if (MODE == 1) { if (n >= O_Q && n < O_VV) { const int dl = (n - O_Q) & 63; return n - dl + rope_phys(dl); } return n; }
    if (MODE == 2) { const int bj = n >= DFF ? 1 : 0, j = n - bj * DFF; return 256 * (j >> 7) + 128 * bj + (j & 127); }
    return n;
}
template <int MODE> DI void transpose_item(const float* W, int K, int N, bf16* WT, LAS float* scr, int item, int lane, const float* gain) {
    const int nblk = N / 32, kb = item / nblk, nb = item % nblk, k0 = 64 * kb, n0 = 32 * nb;
#pragma unroll 8
    for (int i = 0; i < 32; ++i) { const int kk = 2 * i + (lane >> 5); const float g = gain ? gain[k0 + kk] : 1.0f; scr[kk * 33 + (lane & 31)] = W[(size_t)(k0 + kk) * N + n0 + (lane & 31)] * g; }
    LDS_WAIT(); asm volatile("" ::: "memory");
    const int c = lane & 7;
#pragma unroll
    for (int j = 0; j < 4; ++j) { const int n = (lane >> 3) + 8 * j; const LAS float* s = scr + (8 * c) * 33 + n;
        u32x4 o; o.x = cvtpk(s[0 * 33], s[1 * 33]); o.y = cvtpk(s[2 * 33], s[3 * 33]); o.z = cvtpk(s[4 * 33], s[5 * 33]); o.w = cvtpk(s[6 * 33], s[7 * 33]);
        *(u32x4*)(WT + (size_t)wrow_map<MODE>(n0 + n) * K + k0 + 8 * c) = o; }
    LDS_WAIT(); asm volatile("" ::: "memory");
}

DI void prologue(const Args& args, Frame& F) {
    launder(F);
    LAS float* scr = (LAS float*)(F.lds + F.wave * 16384);
    const int gw = F.bid * NWAVES + F.wave, NGW = F.G * NWAVES;
    const int gt = F.bid * NTHR + F.tid, NGT = F.G * NTHR;
    constexpr int I_IN = (DM / 64) * (INW / 32), I_OUT = (DM / 64) * (DM / 32), I_UP = (DM / 64) * (DFF2 / 32), I_DN = (DFF / 64) * (DM / 32), I_GL = (BW / 64) * (BW / 32);
    constexpr int I_L = I_IN + I_OUT + I_UP + I_DN + I_GL;
    for (int it = gw; it < DEPTH * I_L; it += NGW) {
        const int l = it / I_L; int r = it % I_L;
        bf16* wl = (bf16*)(F.ws + WS_W + (size_t)l * W_STRIDE);
        if (r < I_IN) { transpose_item<1>(args.in[8] + (size_t)l * DM * INW, DM, INW, (bf16*)((unsigned char*)wl + W_IN), scr, r, F.lane, args.in[7] + l * DM); continue; } r -= I_IN;
        if (r < I_OUT) { transpose_item<0>(args.in[21] + (size_t)l * DM * DM, DM, DM, (bf16*)((unsigned char*)wl + W_OUT), scr, r, F.lane, nullptr); continue; } r -= I_OUT;
        if (r < I_UP) { transpose_item<2>(args.in[23] + (size_t)l * DM * DFF2, DM, DFF2, (bf16*)((unsigned char*)wl + W_UP), scr, r, F.lane, args.in[22] + l * DM); continue; } r -= I_UP;
        if (r < I_DN) { transpose_item<0>(args.in[26] + (size_t)l * DFF * DM, DFF, DM, (bf16*)((unsigned char*)wl + W_DOWN), scr, r, F.lane, nullptr); continue; } r -= I_DN;
        transpose_item<0>(args.in[19] + (size_t)l * BW * BW, BW, BW, (bf16*)(F.ws + WS_WGLU + (size_t)l * WGLU_STRIDE), scr, r, F.lane, nullptr);
    }
    { bf16* wsm = (bf16*)(F.ws + WS_WSM); const float* ws_ = args.in[9];
      for (int i = gt; i < DEPTH * AH * 128 * 128; i += NGT) { const int jj = i & 127, ii = (i >> 7) & 127; wsm[i] = (jj <= ii) ? f2bf1(ws_[i]) : (unsigned short)0; } }
    for (int i = gt; i < DEPTH * NG * NP; i += NGT) {
        const int l = i / (NG * NP), gp = i % (NG * NP), g = gp / NP, p = gp % NP;
        unsigned char* base = F.ws + WS_S5P + (size_t)l * S5P_STRIDE;
        const double dt = exp((double)args.in[13][l * NG + g]);
        const double lr = (double)args.in[11][i], li = (double)args.in[12][i];
        const double mag = exp(lr * dt), ar = mag * cos(li * dt), ai = mag * sin(li * dt);
        const double nr = ar - 1.0, ni = ai, den = lr * lr + li * li;
        const double fr = (nr * lr + ni * li) / den, fi = (ni * lr - nr * li) / den;
        const double m32 = exp(32.0 * lr * dt), m128 = exp(128.0 * lr * dt);
        float* A = (float*)(base + S5P_A);
        A[0 * 1536 + gp] = (float)ar; A[1 * 1536 + gp] = (float)ai;
        A[2 * 1536 + gp] = (float)(m32 * cos(32.0 * li * dt)); A[3 * 1536 + gp] = (float)(m32 * sin(32.0 * li * dt));
        A[4 * 1536 + gp] = (float)(m128 * cos(128.0 * li * dt)); A[5 * 1536 + gp] = (float)(m128 * sin(128.0 * li * dt));
        bf16* bm = (bf16*)(base + S5P_BMAT) + (size_t)g * 128 * 16;
        const float* bre = args.in[14] + (size_t)i * 16; const float* bim = args.in[15] + (size_t)i * 16;
        for (int c = 0; c < 16; ++c) { const double br = bre[c], bi = bim[c];
            bm[p * 16 + c] = f2bf1((float)(fr * br - fi * bi)); bm[(64 + p) * 16 + c] = f2bf1((float)(fr * bi + fi * br)); }
        bf16* cm = (bf16*)(base + S5P_CMAT) + (size_t)g * 16 * 128;
        const float* cre = args.in[16] + ((size_t)(l * NG + g) * 16) * NP; const float* cim = args.in[17] + ((size_t)(l * NG + g) * 16) * NP;
        for (int c = 0; c < 16; ++c) { cm[c * 128 + p] = f2bf1(cre[c * NP + p]); cm[c * 128 + 64 + p] = f2bf1(-cim[c * NP + p]); }
    }
    { f32x2* rope = (f32x2*)(F.ws + WS_ROPE);
      for (int i = gt; i < (PAST + STOK) * 8; i += NGT) { const int pos = i >> 3, k = i & 7; const double inv = pow(500000.0, -(double)k / 8.0), ang = (double)pos * inv;
          rope[i] = (f32x2){(float)cos(ang), (float)sin(ang)}; } }
    { bf16* XB = (bf16*)(F.ws + WS_XB); float* rss = (float*)(F.ws + WS_RSS);
      for (int row = gw; row < MR; row += NGW) {
          const float* xr = row < MP ? args.in[0] + (size_t)row * DM : args.in[1] + (size_t)(row - MP) * DM;
          const f32x4* x4 = (const f32x4*)xr + F.lane; float s = 0.f; f32x4 v[4];
#pragma unroll
          for (int j = 0; j < 4; ++j) { v[j] = x4[64 * j]; s += (v[j].x * v[j].x + v[j].y * v[j].y) + (v[j].z * v[j].z + v[j].w * v[j].w); }
          s = wave_sum(s);
          u32x2* o = (u32x2*)(XB + (size_t)row * DM) + F.lane;
#pragma unroll
          for (int j = 0; j < 4; ++j) o[64 * j] = (u32x2){cvtpk(v[j].x, v[j].y), cvtpk(v[j].z, v[j].w)};
          if (F.lane < 16) rss[(size_t)row * 16 + F.lane] = (F.lane == 0) ? s : 0.f;
      } }
}

DI int tok_of(int b, int r, int D, int i) { return b * SEQ + r + D * i; }

DI void attn_prompt_unit(Frame& F, int unit) {
    launder(F);
    const int br = unit / 384; int rem = unit % 384; const int b = rem / 192; rem %= 192; const int h = rem / 32; const int blk = rem % 32;
    const int D = br == 0 ? 1 : (br == 1 ? 4 : 16);
    const int nper = (SEQ / D) / 256, r = blk / nper, J = blk % nper;
    const bf16* PROJ = (const bf16*)(F.ws + WS_PROJ);
    LAS unsigned char* Ks = F.lds;
    LAS unsigned char* Vt = F.lds + 384 * 144;
    const int ibase = 256 * J - 128;
#pragma unroll
    for (int it = 0; it < 6; ++it) { const int id = F.tid + NTHR * it, kk = id >> 3, c = id & 7, i = ibase + kk;
        u32x4 v = (u32x4){0u, 0u, 0u, 0u};
        if (i >= 0) v = *(const u32x4*)(PROJ + (size_t)tok_of(b, r, D, i) * INW + O_K + h * HD + 8 * c);
        *(LAS u32x4*)(Ks + kk * 144 + c * 16) = v; }
#pragma unroll
    for (int it = 0; it < 6; ++it) { const int id = F.tid + NTHR * it, c = id / 384, kk = id % 384, i = ibase + kk;
        u32x4 v = (u32x4){0u, 0u, 0u, 0u};
        if (i >= 0) v = *(const u32x4*)(PROJ + (size_t)tok_of(b, r, D, i) * INW + O_VV + h * HD + 8 * c);
        LAS unsigned short* vt = (LAS unsigned short*)(Vt + (8 * c) * 776 + kk * 2);
        vt[0 * 388] = (unsigned short)(v.x & 0xffffu); vt[1 * 388] = (unsigned short)(v.x >> 16);
        vt[2 * 388] = (unsigned short)(v.y & 0xffffu); vt[3 * 388] = (unsigned short)(v.y >> 16);
        vt[4 * 388] = (unsigned short)(v.z & 0xffffu); vt[5 * 388] = (unsigned short)(v.z >> 16);
        vt[6 * 388] = (unsigned short)(v.w & 0xffffu); vt[7 * 388] = (unsigned short)(v.w >> 16); }
    const int w = F.wave, l31 = F.lane & 31, hh = F.lane >> 5;
    const int qi = 256 * J + 32 * w + l31, qtok = tok_of(b, r, D, qi);
    bf16x8 qf[4];
#pragma unroll
    for (int s = 0; s < 4; ++s) qf[s] = *(const bf16x8*)(PROJ + (size_t)qtok * INW + O_Q + h * HD + 16 * s + 8 * hh);
    __syncthreads();
    f32x16 S[5];
#pragma unroll
    for (int t = 0; t < 5; ++t) { S[t] = zero16();
#pragma unroll
        for (int s = 0; s < 4; ++s) { const bf16x8 kf = *(const LAS bf16x8*)(Ks + (32 * w + 32 * t + l31) * 144 + (16 * s + 8 * hh) * 2); S[t] = mfma32(kf, qf[s], S[t]); } }
    float mx = -3.0e38f;
#pragma unroll
    for (int t = 0; t < 5; ++t)
#pragma unroll
        for (int rg = 0; rg < 16; ++rg) { const int kw = 32 * t + crow(rg, hh); const bool ok = (kw >= l31) && (kw <= l31 + 128) && (ibase + 32 * w + kw >= 0);
            S[t][rg] = ok ? S[t][rg] : -3.0e38f; mx = fmaxf(mx, S[t][rg]); }
    mx = fmaxf(mx, __shfl_xor(mx, 32));
    const float c2 = 0.125f * 1.4426950409f; float lsum = 0.f;
#pragma unroll
    for (int t = 0; t < 5; ++t)
#pragma unroll
        for (int rg = 0; rg < 16; ++rg) { const float p = (S[t][rg] > -1.0e38f) ? __builtin_amdgcn_exp2f((S[t][rg] - mx) * c2) : 0.f; S[t][rg] = p; lsum += p; }
    lsum += __shfl_xor(lsum, 32);
    f32x16 O[2]; O[0] = zero16(); O[1] = zero16();
#pragma unroll
    for (int t = 0; t < 5; ++t)
#pragma unroll
        for (int s2 = 0; s2 < 2; ++s2) {
            u32x4 pw; pw.x = cvtpk(S[t][8 * s2 + 0], S[t][8 * s2 + 1]); pw.y = cvtpk(S[t][8 * s2 + 2], S[t][8 * s2 + 3]); pw.z = cvtpk(S[t][8 * s2 + 4], S[t][8 * s2 + 5]); pw.w = cvtpk(S[t][8 * s2 + 6], S[t][8 * s2 + 7]);
            const bf16x8 pf = __builtin_bit_cast(bf16x8, pw);
#pragma unroll
            for (int dt = 0; dt < 2; ++dt) {
                const LAS unsigned char* vp = Vt + (32 * dt + l31) * 776 + (32 * w + 32 * t + 16 * s2 + 4 * hh) * 2;
                const u32x2 lo = *(const LAS u32x2*)vp, hi2 = *(const LAS u32x2*)(vp + 16);
                const u32x4 vv = (u32x4){lo.x, lo.y, hi2.x, hi2.y};
                O[dt] = mfma32(__builtin_bit_cast(bf16x8, vv), pf, O[dt]);
            }
        }
    const float inv = 1.0f / lsum;
    bf16* OP = (bf16*)(F.ws + WS_OP) + ((size_t)br * MP + qtok) * CWD + h * HD;
#pragma unroll
    for (int dt = 0; dt < 2; ++dt)
#pragma unroll
        for (int g4 = 0; g4 < 4; ++g4) { u32x2 o; o.x = cvtpk(O[dt][4 * g4] * inv, O[dt][4 * g4 + 1] * inv); o.y = cvtpk(O[dt][4 * g4 + 2] * inv, O[dt][4 * g4 + 3] * inv);
            *(u32x2*)(OP + 32 * dt + 8 * g4 + 4 * hh) = o; }
    if (hh == 0) ((float*)(F.ws + WS_LSE))[((size_t)br * MP + qtok) * CH + h] = mx * 0.125f + __logf(lsum);
    __syncthreads();
}

DI void sgu_prompt_unit(const Args& args, Frame& F, int layer, int ch) {
    launder(F);
    const int R0 = (ch >> 6) * SEQ + (ch & 63) * 128;
    const bf16* PROJ = (const bf16*)(F.ws + WS_PROJ);
    LAS unsigned char* VnT = F.lds;
    LAS f32x2* part = (LAS f32x2*)(F.lds + 256 * 272);
    const int tok = F.tid & 127, qtr = F.tid >> 7;
    u32x4 raw[8]; float s = 0.f, sq = 0.f;
#pragma unroll
    for (int c = 0; c < 8; ++c) { raw[c] = *(const u32x4*)(PROJ + (size_t)(R0 + tok) * INW + O_V + 64 * qtr + 8 * c);
#pragma unroll
        for (int e = 0; e < 4; ++e) { const unsigned wv = raw[c][e]; const float a = __uint_as_float(wv << 16), bq = __uint_as_float(wv & 0xffff0000u); s += a + bq; sq += a * a + bq * bq; } }
    part[qtr * 128 + tok] = (f32x2){s, sq};
    __syncthreads();
    { const f32x2 p0 = part[tok], p1 = part[128 + tok], p2 = part[256 + tok], p3 = part[384 + tok];
      const float mean = ((p0.x + p1.x) + (p2.x + p3.x)) * (1.0f / 256.0f), ex2 = ((p0.y + p1.y) + (p2.y + p3.y)) * (1.0f / 256.0f);
      const float var = fmaxf(ex2 - mean * mean, 0.f), rstd = 1.0f / sqrtf(var + EPSN);
#pragma unroll
      for (int c = 0; c < 8; ++c)
#pragma unroll
          for (int e = 0; e < 4; ++e) { const unsigned wv = raw[c][e]; const float a = (__uint_as_float(wv << 16) - mean) * rstd, bq = (__uint_as_float(wv & 0xffff0000u) - mean) * rstd;
              const unsigned pk = cvtpk(a, bq); const int d = 64 * qtr + 8 * c + 2 * e;
              *(LAS unsigned short*)(VnT + d * 272 + tok * 2) = (unsigned short)(pk & 0xffffu); *(LAS unsigned short*)(VnT + (d + 1) * 272 + tok * 2) = (unsigned short)(pk >> 16); } }
    __syncthreads();
    const int w = F.wave, hd = w >> 1, ih = w & 1, l31 = F.lane & 31, hh = F.lane >> 5;
    const bf16* Wm = (const bf16*)(F.ws + WS_WSM) + ((size_t)(layer * AH + hd) * 128) * 128;
    f32x16 acc[2][2]; acc[0][0] = zero16(); acc[0][1] = zero16(); acc[1][0] = zero16(); acc[1][1] = zero16();
    const int ks = 4 * (ih + 1);
    for (int s2 = 0; s2 < ks; ++s2) {
        bf16x8 af[2], bfr[2];
#pragma unroll
        for (int mt = 0; mt < 2; ++mt) af[mt] = *(const bf16x8*)(Wm + (size_t)(64 * ih + 32 * mt + l31) * 128 + 16 * s2 + 8 * hh);
#pragma unroll
        for (int nt = 0; nt < 2; ++nt) bfr[nt] = *(const LAS bf16x8*)(VnT + (64 * hd + 32 * nt + l31) * 272 + (16 * s2 + 8 * hh) * 2);
#pragma unroll
        for (int mt = 0; mt < 2; ++mt)
#pragma unroll
            for (int nt = 0; nt < 2; ++nt) acc[mt][nt] = mfma32(af[mt], bfr[nt], acc[mt][nt]);
    }
    const float* bs = args.in[10] + (size_t)(layer * AH + hd) * 128;
    bf16* MIX = (bf16*)(F.ws + WS_MIX);
#pragma unroll
    for (int mt = 0; mt < 2; ++mt)
#pragma unroll
        for (int rg = 0; rg < 16; ++rg) { const int i = 64 * ih + 32 * mt + crow(rg, hh); const float bb = bs[i];
#pragma unroll
            for (int nt = 0; nt < 2; ++nt) { const int d = 64 * hd + 32 * nt + l31; const float uu = bf2f(PROJ[(size_t)(R0 + i) * INW + O_U + d]);
                MIX[(size_t)(R0 + i) * DM + d] = f2bf1(uu * (acc[mt][nt][rg] + bb)); } }
    __syncthreads();
}

struct S5W { bf16x8 bfr[4]; float ar0, ai0, ar1, ai1; };
DI void s5_load_group(Frame& F, int layer, int g, S5W& W) {
    const unsigned char* base = F.ws + WS_S5P + (size_t)layer * S5P_STRIDE; const int l31 = F.lane & 31, hh = F.lane >> 5;
    const bf16* bm = (const bf16*)(base + S5P_BMAT) + (size_t)g * 128 * 16;
#pragma unroll
    for (int nt = 0; nt < 4; ++nt) W.bfr[nt] = *(const bf16x8*)(bm + (32 * nt + l31) * 16 + 8 * hh);
    const float* A = (const float*)(base + S5P_A);
    W.ar0 = A[g * NP + l31]; W.ai0 = A[1536 + g * NP + l31]; W.ar1 = A[g * NP + 32 + l31]; W.ai1 = A[1536 + g * NP + 32 + l31];
}
DI void s5_tile(Frame& F, const S5W& W, int g, int tbase, f32x16 (&X)[4], float& hr0, float& hi0, float& hr1, float& hi1) {
    const bf16* PROJ = (const bf16*)(F.ws + WS_PROJ); const int l31 = F.lane & 31, hh = F.lane >> 5;
    const int tt = (l31 & 3) + 4 * (l31 >> 3), bb = (l31 >> 2) & 1;
    const bf16x8 af = *(const bf16x8*)(PROJ + (size_t)(bb * SEQ + tbase + tt) * INW + O_S5 + 16 * g + 8 * hh);
#pragma unroll
    for (int nt = 0; nt < 4; ++nt) X[nt] = mfma32(af, W.bfr[nt], zero16());
#pragma unroll
    for (int rg = 0; rg < 16; ++rg) {
        const float nr0 = W.ar0 * hr0 - W.ai0 * hi0 + X[0][rg], ni0 = W.ar0 * hi0 + W.ai0 * hr0 + X[2][rg];
        const float nr1 = W.ar1 * hr1 - W.ai1 * hi1 + X[1][rg], ni1 = W.ar1 * hi1 + W.ai1 * hr1 + X[3][rg];
        hr0 = nr0; hi0 = ni0; hr1 = nr1; hi1 = ni1; X[0][rg] = nr0; X[2][rg] = ni0; X[1][rg] = nr1; X[3][rg] = ni1;
    }
}
DI void s5_pass1_task(Frame& F, int layer, int C, int g) {
    launder(F);
    S5W W; s5_load_group(F, layer, g, W);
    const int l31 = F.lane & 31, hh = F.lane >> 5;
    float hr0 = 0.f, hi0 = 0.f, hr1 = 0.f, hi1 = 0.f;
    f32x2* L = (f32x2*)(F.ws + WS_S5L);
    for (int k = 0; k < 8; ++k) {
        f32x16 X[4]; s5_tile(F, W, g, 128 * C + 16 * k, X, hr0, hi0, hr1, hi1);
        if (k & 1) { const size_t idx = ((((size_t)C * 4 + (k >> 1)) * 2 + hh) * NG + g) * NP + l31; L[idx] = (f32x2){hr0, hi0}; L[idx + 32] = (f32x2){hr1, hi1}; }
    }
}

DI void sgu_sample_unit(const Args& args, Frame& F, int layer, int sb) {
    launder(F);
    const bf16* PROJ = (const bf16*)(F.ws + WS_PROJ); const int R0 = MP + sb * STOK;
    LAS float* vn = (LAS float*)F.lds;
    { const int t = F.wave; const bf16* vr = PROJ + (size_t)(R0 + t) * INW + O_V + 4 * F.lane;
      const u32x2 rw = *(const u32x2*)vr; float v[4] = {__uint_as_float(rw.x << 16), __uint_as_float(rw.x & 0xffff0000u), __uint_as_float(rw.y << 16), __uint_as_float(rw.y & 0xffff0000u)};
      const float mean = wave_sum((v[0] + v[1]) + (v[2] + v[3])) * (1.0f / 256.0f);
      float q = 0.f;
#pragma unroll
      for (int e = 0; e < 4; ++e) { v[e] -= mean; q += v[e] * v[e]; }
      const float rstd = 1.0f / sqrtf(wave_sum(q) * (1.0f / 256.0f) + EPSN);
      float* sg = F.out + OUT_SGV + ((size_t)(layer * SBATCH + sb) * STOK + t) * AW + 4 * F.lane;
#pragma unroll
      for (int e = 0; e < 4; ++e) { v[e] *= rstd; vn[t * 256 + 4 * F.lane + e] = v[e]; }
      *(f32x4*)sg = (f32x4){v[0], v[1], v[2], v[3]}; }
    __syncthreads();
    bf16* MIX = (bf16*)(F.ws + WS_MIX);
#pragma unroll
    for (int q = 0; q < 4; ++q) { const int o = F.tid + NTHR * q, i = o >> 8, col = o & 255, hd = col >> 6;
        const float* wr = args.in[9] + ((size_t)(layer * AH + hd) * 128 + i) * 128;
        float a = args.in[10][(size_t)(layer * AH + hd) * 128 + i];
        for (int j = 0; j <= i; ++j) a += wr[j] * vn[j * 256 + col];
        const float uu = bf2f(PROJ[(size_t)(R0 + i) * INW + O_U + col]);
        MIX[(size_t)(R0 + i) * DM + col] = f2bf1(uu * a); }
    __syncthreads();
}

DI void s5_sample_unit(const Args& args, Frame& F, int layer, int sb) {
    launder(F);
    const bf16* PROJ = (const bf16*)(F.ws + WS_PROJ); const int R0 = MP + sb * STOK;
    const unsigned char* base = F.ws + WS_S5P + (size_t)layer * S5P_STRIDE;
    LAS float* us = (LAS float*)F.lds;
    LAS float* gs = us + 8 * 384;
    LAS float* hs = gs + 8 * 384;
    for (int i = F.tid; i < 8 * 384; i += NTHR) { const int t = i / 384, c = i % 384; us[i] = bf2f(PROJ[(size_t)(R0 + t) * INW + O_S5 + c]); }
    __syncthreads();
    LAS float* hw = hs + F.wave * (8 * 64 * 2);
    for (int gi = 0; gi < 3; ++gi) {
        const int g = 3 * F.wave + gi, p = F.lane;
        const bf16* bm = (const bf16*)(base + S5P_BMAT) + (size_t)g * 128 * 16;
        const float* A = (const float*)(base + S5P_A);
        const float ar = A[g * NP + p], ai = A[1536 + g * NP + p];
        float bre[16], bim[16];
        { const u32x4* b0 = (const u32x4*)(bm + p * 16); const u32x4* b1 = (const u32x4*)(bm + (64 + p) * 16);
#pragma unroll
          for (int q = 0; q < 2; ++q) { const u32x4 x = b0[q], y = b1[q];
#pragma unroll
              for (int e = 0; e < 4; ++e) { bre[8 * q + 2 * e] = __uint_as_float(x[e] << 16); bre[8 * q + 2 * e + 1] = __uint_as_float(x[e] & 0xffff0000u);
                                             bim[8 * q + 2 * e] = __uint_as_float(y[e] << 16); bim[8 * q + 2 * e + 1] = __uint_as_float(y[e] & 0xffff0000u); } } }
        const size_t sidx = ((size_t)(layer * SBATCH + sb) * NG + g) * NP + p;
        float hr = args.in[4][sidx], hi = args.in[5][sidx];
#pragma unroll
        for (int t = 0; t < 8; ++t) {
            float xr = 0.f, xi = 0.f;
#pragma unroll
            for (int c = 0; c < 16; ++c) { const float uu = us[t * 384 + 16 * g + c]; xr += bre[c] * uu; xi += bim[c] * uu; }
            const float nr = ar * hr - ai * hi + xr, ni = ar * hi + ai * hr + xi; hr = nr; hi = ni;
            hw[(t * 64 + p) * 2] = hr; hw[(t * 64 + p) * 2 + 1] = hi;
        }
        F.out[OUT_SRS + sidx] = hr; F.out[OUT_SIS + sidx] = hi;
        LDS_WAIT(); asm volatile("" ::: "memory");
        const bf16* cm = (const bf16*)(base + S5P_CMAT) + (size_t)g * 16 * 128;
        const int t = F.lane >> 3, c0 = F.lane & 7;
        float y0 = 0.f, y1 = 0.f;
        for (int pp = 0; pp < 64; ++pp) { const float hre = hw[(t * 64 + pp) * 2], him = hw[(t * 64 + pp) * 2 + 1];
            y0 += bf2f(cm[c0 * 128 + pp]) * hre + bf2f(cm[c0 * 128 + 64 + pp]) * him;
            y1 += bf2f(cm[(c0 + 8) * 128 + pp]) * hre + bf2f(cm[(c0 + 8) * 128 + 64 + pp]) * him; }
        const float* dsk = args.in[18] + (size_t)layer * BW + 16 * g;
        y0 += dsk[c0] * us[t * 384 + 16 * g + c0]; y1 += dsk[c0 + 8] * us[t * 384 + 16 * g + c0 + 8];
        gs[t * 384 + 16 * g + c0] = gelu_t(y0); gs[t * 384 + 16 * g + c0 + 8] = gelu_t(y1);
        LDS_WAIT(); asm volatile("" ::: "memory");
    }
    __syncthreads();
    bf16* MIX = (bf16*)(F.ws + WS_MIX);
    const float* wg = args.in[19] + (size_t)layer * BW * BW; const float* bg = args.in[20] + (size_t)layer * BW;
    for (int q = 0; q < 6; ++q) { const int o = F.tid + NTHR * q, t = o / 384, n = o % 384;
        float a = bg[n];
        for (int k = 0; k < 384; ++k) a += gs[t * 384 + k] * wg[(size_t)k * BW + n];
        MIX[(size_t)(R0 + t) * DM + AW + n] = f2bf1(gs[t * 384 + n] * sigmoid_f(a)); }
    __syncthreads();
}

DI void attn_sample_unit(const Args& args, Frame& F, int layer, int unit) {
    launder(F);
    const int sb = unit / CH, h = unit % CH, i = F.wave, lane = F.lane;
    const bf16* PROJ = (const bf16*)(F.ws + WS_PROJ); const int R0 = MP + sb * STOK;
    LAS float* qs = (LAS float*)F.lds + F.wave * 64;
    LAS float* ps = (LAS float*)F.lds + 8 * 64 + F.wave * 192;
    { const int p = rope_phys(lane); qs[lane] = bf2f(PROJ[(size_t)(R0 + i) * INW + O_Q + h * HD + p]); }
    LDS_WAIT(); asm volatile("" ::: "memory");
    const float* ck = args.in[2] + ((size_t)(layer * SBATCH + sb) * CWIN) * CWD + h * HD;
    const float* cv = args.in[3] + ((size_t)(layer * SBATCH + sb) * CWIN) * CWD + h * HD;
    const float* nk = F.out + OUT_KS + ((size_t)(layer * MS + sb * STOK) * CH + h) * HD;
    const float* nv = F.out + OUT_VS + ((size_t)(layer * MS + sb * STOK) * CH + h) * HD;
    float ob0 = 0.f, ob1 = 0.f, ob2 = 0.f, ls0 = 0.f, ls1 = 0.f, ls2 = 0.f;
#pragma unroll 1
    for (int br = 0; br < 3; ++br) {
        const int dil = br == 0 ? 1 : (br == 1 ? 4 : 16);
        float sc0 = 0.f, sc1 = 0.f, sc2 = 0.f;
#pragma unroll 1
        for (int jj = 0; jj < 3; ++jj) { const int j = lane + 64 * jj; float a = -3.0e38f;
            if (j <= 128) { const int kp = PAST + i - dil * j; a = 0.f;
                const f32x4* kr = (const f32x4*)(kp < PAST ? ck + (size_t)(kp - (PAST - CWIN)) * CWD : nk + (size_t)(kp - PAST) * CWD);
#pragma unroll
                for (int c = 0; c < 16; ++c) { const f32x4 kv = kr[c]; a += kv.x * qs[4 * c] + kv.y * qs[4 * c + 1] + kv.z * qs[4 * c + 2] + kv.w * qs[4 * c + 3]; }
                a *= 0.125f; }
            if (jj == 0) sc0 = a; else if (jj == 1) sc1 = a; else sc2 = a; }
        const float mx = wave_max(fmaxf(fmaxf(sc0, sc1), sc2));
        float lsum = 0.f;
        { const float p0 = __expf(sc0 - mx), p1 = __expf(sc1 - mx), p2 = (lane == 0) ? __expf(sc2 - mx) : 0.f; lsum = p0 + p1 + p2; ps[lane] = p0; ps[lane + 64] = p1; if (lane == 0) ps[128] = p2; }
        lsum = wave_sum(lsum);
        LDS_WAIT(); asm volatile("" ::: "memory");
        float o = 0.f;
#pragma unroll 8
        for (int j = 0; j < 128; ++j) { const int kp = PAST + i - dil * j;
            const float* vr = kp < PAST ? cv + (size_t)(kp - (PAST - CWIN)) * CWD : nv + (size_t)(kp - PAST) * CWD;
            o += ps[j] * vr[lane]; }
        { const int kp = PAST + i - dil * 128; o += ps[128] * cv[(size_t)(kp - (PAST - CWIN)) * CWD + lane]; }
        { const float ov = o / lsum, lv = mx + __logf(lsum); if (br == 0) { ob0 = ov; ls0 = lv; } else if (br == 1) { ob1 = ov; ls1 = lv; } else { ob2 = ov; ls2 = lv; } }
        LDS_WAIT(); asm volatile("" ::: "memory");
    }
    const float ml = fmaxf(fmaxf(ls0, ls1), ls2);
    const float w0 = __expf(ls0 - ml), w1 = __expf(ls1 - ml), w2 = __expf(ls2 - ml);
    const float res = (w0 * ob0 + w1 * ob1 + w2 * ob2) / (w0 + w1 + w2);
    ((bf16*)(F.ws + WS_MIX))[(size_t)(R0 + i) * DM + AW + BW + h * HD + lane] = f2bf1(res);
    __syncthreads();
}

DI void attn_merge(Frame& F) {
    launder(F);
    const bf16* OP = (const bf16*)(F.ws + WS_OP); const float* LSE = (const float*)(F.ws + WS_LSE); bf16* MIX = (bf16*)(F.ws + WS_MIX);
    const int gt = F.bid * NTHR + F.tid, NGT = F.G * NTHR;
    for (int i = gt; i < MP * CH * 8; i += NGT) { const int c = i & 7, th = i >> 3, h = th % CH, tok = th / CH;
        const float l0 = LSE[(size_t)tok * CH + h], l1 = LSE[((size_t)MP + tok) * CH + h], l2 = LSE[((size_t)2 * MP + tok) * CH + h];
        const float ml = fmaxf(fmaxf(l0, l1), l2); float w0 = __expf(l0 - ml), w1 = __expf(l1 - ml), w2 = __expf(l2 - ml); const float iw = 1.0f / (w0 + w1 + w2); w0 *= iw; w1 *= iw; w2 *= iw;
        const u32x4 a = *(const u32x4*)(OP + (size_t)tok * CWD + h * HD + 8 * c), b = *(const u32x4*)(OP + ((size_t)MP + tok) * CWD + h * HD + 8 * c), d = *(const u32x4*)(OP + ((size_t)2 * MP + tok) * CWD + h * HD + 8 * c);
        u32x4 o;
#pragma unroll
        for (int e = 0; e < 4; ++e) { const float lo = w0 * __uint_as_float(a[e] << 16) + w1 * __uint_as_float(b[e] << 16) + w2 * __uint_as_float(d[e] << 16);
            const float hi = w0 * __uint_as_float(a[e] & 0xffff0000u) + w1 * __uint_as_float(b[e] & 0xffff0000u) + w2 * __uint_as_float(d[e] & 0xffff0000u); o[e] = cvtpk(lo, hi); }
        *(u32x4*)(MIX + (size_t)tok * DM + AW + BW + h * HD + 8 * c) = o; }
}

DI void cmul_acc(float& hr, float& hi, float ar, float ai, float xr, float xi) { const float nr = ar * hr - ai * hi + xr, ni = ar * hi + ai * hr + xi; hr = nr; hi = ni; }

DI void s5_pass2_unit(const Args& args, Frame& F, int layer, int sc) {
    launder(F);
    const int C = sc >> 2, j = sc & 3, t0 = 32 * sc;
    const bf16* PROJ = (const bf16*)(F.ws + WS_PROJ);
    const unsigned char* base = F.ws + WS_S5P + (size_t)layer * S5P_STRIDE;
    const int l31 = F.lane & 31, hh = F.lane >> 5, w = F.wave;
    LAS unsigned char* img = F.lds + w * 8192;
    LAS unsigned char* Gs = F.lds + 65536;
    const f32x2* L = (const f32x2*)(F.ws + WS_S5L);
    const float* A = (const float*)(base + S5P_A);
#pragma unroll 1
    for (int gi = 0; gi < 3; ++gi) {
        const int g = 3 * w + gi;
        S5W W; s5_load_group(F, layer, g, W);
        float hr0 = 0.f, hi0 = 0.f, hr1 = 0.f, hi1 = 0.f;
        { const float br0 = A[4 * 1536 + g * NP + l31], bi0 = A[5 * 1536 + g * NP + l31], br1 = A[4 * 1536 + g * NP + 32 + l31], bi1 = A[5 * 1536 + g * NP + 32 + l31];
#pragma unroll 2
          for (int cc = 0; cc < C; ++cc) { const size_t idx = ((((size_t)cc * 4 + 3) * 2 + hh) * NG + g) * NP + l31; const f32x2 e0 = L[idx], e1 = L[idx + 32];
              cmul_acc(hr0, hi0, br0, bi0, e0.x, e0.y); cmul_acc(hr1, hi1, br1, bi1, e1.x, e1.y); }
          if (j > 0) { const float cr0 = A[2 * 1536 + g * NP + l31], ci0 = A[3 * 1536 + g * NP + l31], cr1 = A[2 * 1536 + g * NP + 32 + l31], ci1 = A[3 * 1536 + g * NP + 32 + l31];
              for (int q = 0; q < j; ++q) { cmul_acc(hr0, hi0, cr0, ci0, 0.f, 0.f); cmul_acc(hr1, hi1, cr1, ci1, 0.f, 0.f); }
              const size_t idx = ((((size_t)C * 4 + (j - 1)) * 2 + hh) * NG + g) * NP + l31; const f32x2 e0 = L[idx], e1 = L[idx + 32];
              hr0 += e0.x; hi0 += e0.y; hr1 += e1.x; hi1 += e1.y; } }
        const bf16* cm = (const bf16*)(base + S5P_CMAT) + (size_t)g * 16 * 128;
        bf16x8 cf[8];
#pragma unroll
        for (int s = 0; s < 8; ++s) { u32x4 z = (u32x4){0u, 0u, 0u, 0u}; if (l31 < 16) z = *(const u32x4*)(cm + l31 * 128 + 16 * s + 8 * hh); cf[s] = __builtin_bit_cast(bf16x8, z); }
        const float dsk = (l31 < 16) ? args.in[18][(size_t)layer * BW + 16 * g + l31] : 0.f;
#pragma unroll 1
        for (int k = 0; k < 2; ++k) {
            f32x16 X[4]; s5_tile(F, W, g, t0 + 16 * k, X, hr0, hi0, hr1, hi1);
#pragma unroll
            for (int nt = 0; nt < 4; ++nt)
#pragma unroll
                for (int g4 = 0; g4 < 4; ++g4) { u32x2 pk; pk.x = cvtpk(X[nt][4 * g4], X[nt][4 * g4 + 1]); pk.y = cvtpk(X[nt][4 * g4 + 2], X[nt][4 * g4 + 3]);
                    *(LAS u32x2*)(img + nt * 2048 + l31 * 64 + 8 * (2 * g4 + hh)) = pk; }
            LDS_WAIT(); asm volatile("" ::: "memory");
            f32x16 Y = zero16();
            const int i16 = F.lane & 15, q = i16 >> 2, pp = i16 & 3, blk = (F.lane >> 4) & 1;
#pragma unroll
            for (int nt = 0; nt < 4; ++nt)
#pragma unroll
                for (int s = 0; s < 2; ++s) {
                    const s16x4 lo = __builtin_bit_cast(s16x4, __builtin_amdgcn_ds_read_tr16_b64_v4i16((LAS s16x4*)(img + nt * 2048 + (16 * s + 8 * hh + q) * 64 + 8 * (4 * blk + pp))));
                    const s16x4 hi4 = __builtin_bit_cast(s16x4, __builtin_amdgcn_ds_read_tr16_b64_v4i16((LAS s16x4*)(img + nt * 2048 + (16 * s + 8 * hh + 4 + q) * 64 + 8 * (4 * blk + pp))));
                    const bf16x8 xa = __builtin_shufflevector(lo, hi4, 0, 1, 2, 3, 4, 5, 6, 7);
                    Y = mfma32(xa, cf[2 * nt + s], Y);
                }
            LDS_WAIT(); asm volatile("" ::: "memory");
            if (l31 < 16) {
                const int chn = 16 * g + l31;
#pragma unroll
                for (int rg = 0; rg < 16; ++rg) { const float uu = bf2f(PROJ[(size_t)(hh * SEQ + t0 + 16 * k + rg) * INW + O_S5 + chn]);
                    *(LAS unsigned short*)(Gs + (32 * hh + 16 * k + rg) * 784 + chn * 2) = f2bf1(gelu_t(Y[rg] + dsk * uu)); }
            }
        }
        if (sc == 255) { const size_t o = ((size_t)(layer * NBATCH + hh) * NG + g) * NP + l31;
            F.out[OUT_SRP + o] = hr0; F.out[OUT_SIP + o] = hi0; F.out[OUT_SRP + o + 32] = hr1; F.out[OUT_SIP + o + 32] = hi1; }
    }
    __syncthreads();
    { const int mt = w >> 2, ng = w & 3;
      const bf16* wg = (const bf16*)(F.ws + WS_WGLU + (size_t)layer * WGLU_STRIDE);
      f32x16 acc[3]; acc[0] = zero16(); acc[1] = zero16(); acc[2] = zero16();
      for (int s = 0; s < 24; ++s) {
          const bf16x8 af = *(const LAS bf16x8*)(Gs + (32 * mt + l31) * 784 + (16 * s + 8 * hh) * 2);
#pragma unroll
          for (int nt = 0; nt < 3; ++nt) { const bf16x8 bfr = *(const bf16x8*)(wg + (size_t)(96 * ng + 32 * nt + l31) * BW + 16 * s + 8 * hh); acc[nt] = mfma32(af, bfr, acc[nt]); }
      }
      bf16* MIX = (bf16*)(F.ws + WS_MIX); const float* bg = args.in[20] + (size_t)layer * BW;
#pragma unroll
      for (int nt = 0; nt < 3; ++nt) { const int n = 96 * ng + 32 * nt + l31; const float bb = bg[n];
#pragma unroll
          for (int rg = 0; rg < 16; ++rg) { const int grow = 32 * mt + crow(rg, hh); const float gv = bf2f(*(const LAS unsigned short*)(Gs + grow * 784 + n * 2));
              const int tok = (grow >> 5) * SEQ + t0 + (grow & 31);
              MIX[(size_t)tok * DM + AW + n] = f2bf1(gv * sigmoid_f(acc[nt][rg] + bb)); } } }
    __syncthreads();
}

DI void conv_gate(const Args& args, Frame& F, int layer) {
    launder(F);
    const bf16* HB = (const bf16*)(F.ws + WS_HB); bf16* A2 = (bf16*)(F.ws + WS_A2);
    const float* cw = args.in[24] + (size_t)layer * 3 * DFF2; const float* cb = args.in[25] + (size_t)layer * DFF2;
    const float* sbuf = args.in[6] + (size_t)layer * SBATCH * 2 * DFF2;
    const int gt = F.bid * NTHR + F.tid, NGT = F.G * NTHR;
    constexpr int NCH = DFF / 8;
    for (int i = gt; i < MR * NCH; i += NGT) { const int row = i / NCH, j0 = (i % NCH) * 8;
        int t, sbi = -1; if (row < MP) t = row & (SEQ - 1); else { t = (row - MP) & 7; sbi = (row - MP) >> 3; }
        float hc[2][8];
#pragma unroll
        for (int half = 0; half < 2; ++half) { const int col = half * DFF + j0;
#pragma unroll
            for (int e = 0; e < 8; ++e) hc[half][e] = cb[col + e];
#pragma unroll
            for (int tap = 0; tap < 3; ++tap) { const int back = 2 - tap;
                float hv[8]; bool have = true;
                if (t - back >= 0) { const u32x4 rw = *(const u32x4*)(HB + (size_t)(row - back) * DFF2 + col);
#pragma unroll
                    for (int e = 0; e < 4; ++e) { hv[2 * e] = __uint_as_float(rw[e] << 16); hv[2 * e + 1] = __uint_as_float(rw[e] & 0xffff0000u); } }
                else if (sbi >= 0) { const float* sp = sbuf + ((size_t)sbi * 2 + (t - back + 2)) * DFF2 + col;
#pragma unroll
                    for (int e = 0; e < 8; ++e) hv[e] = sp[e]; }
                else have = false;
                if (have) {
#pragma unroll
                    for (int e = 0; e < 8; ++e) hc[half][e] += cw[(size_t)tap * DFF2 + col + e] * hv[e]; }
            } }
        float o[8];
#pragma unroll
        for (int e = 0; e < 8; ++e) o[e] = gelu_t(hc[0][e]) * hc[1][e];
        store8_bf16(A2 + (size_t)row * DFF + j0, o); }
}

DI void final_norm(const Args& args, Frame& F) {
    launder(F);
    const float* X = (const float*)(F.ws + WS_X); const float* rss = (const float*)(F.ws + WS_RSS); const float* fg = args.in[27];
    const int gw = F.bid * NWAVES + F.wave, NGW = F.G * NWAVES;
    for (int row = gw; row < MR; row += NGW) { const float rstd = row_rstd(rss, row);
        float* o = row < MP ? F.out + OUT_YP + (size_t)row * DM : F.out + OUT_YS + (size_t)(row - MP) * DM;
#pragma unroll
        for (int jq = 0; jq < 4; ++jq) { const f32x4 v = ((const f32x4*)(X + (size_t)row * DM))[F.lane + 64 * jq], gq = ((const f32x4*)fg)[F.lane + 64 * jq];
            ((f32x4*)o)[F.lane + 64 * jq] = (f32x4){v.x * rstd * gq.x, v.y * rstd * gq.y, v.z * rstd * gq.z, v.w * rstd * gq.w}; } }
}

constexpr int N_PHASES = 30;

__global__ void __launch_bounds__(NTHR, 2) hymba_fwd(Args args) {
    extern __shared__ __attribute__((aligned(16))) unsigned char lds_raw[];
    Frame F;
    F.lds = (LAS unsigned char*)lds_raw;
    F.tid = threadIdx.x; F.lane = F.tid & 63; F.wave = __builtin_amdgcn_readfirstlane(F.tid >> 6); F.G = gridDim.x; F.bid = blockIdx.x;
    F.out = args.out; F.ws = args.ws;
    volatile LAS unsigned* MISC = (volatile LAS unsigned*)(F.lds + MISC_OFF);
    for (int u = F.tid; u < (LDS_BYTES - LDSCTL_OFF) / 4; u += NTHR) ((LAS unsigned*)(F.lds + LDSCTL_OFF))[u] = 0u;
    __syncthreads();
    unsigned* ctl = (unsigned*)(F.ws + WS_CTL);
    XcdBarrier bar = xcd_barrier_post(ctl + CW_BAR, MISC + 8);
    const int lo = args.ph_lo, hi = args.ph_hi;
#define IN(k) (lo <= (k) && (k) < hi)
#define SEAM(k) do { if (IN(k) && IN((k) + 1)) xcd_barrier(bar); } while (0)

    #ifndef DIS_PRO
    if (IN(0)) { prologue(args, F); }
#endif
    SEAM(0);

    for (int l = 0; l < DEPTH; ++l) {
        const int pb = 1 + 7 * l;
#ifndef DIS_G1
        if (IN(pb + 0)) { const int ll = launder_i(l); unsigned char* wl = F.ws + WS_W + (size_t)ll * W_STRIDE; (void)wl;
            pg8::Gemm g{(const bf16*)(F.ws + WS_XB), (const bf16*)(wl + W_IN), MR, INW, DM}; pg8::StaticOrder S; S.init(MR, INW, launder_i(F.G), launder_i(F.bid));
            EpiIn E{(bf16*)(F.ws + WS_PROJ), (const float*)(F.ws + WS_RSS), (const f32x2*)(F.ws + WS_ROPE), F.out, ll};
            pg8::gemm_phase<EpiIn, pg8::StaticOrder, true, true>(F.lds, g, S, E, launder_i(F.wave));
        }
#endif
        SEAM(pb + 0);
#ifndef DIS_P2
        if (IN(pb + 1)) { const int ll = launder_i(l); unsigned char* wl = F.ws + WS_W + (size_t)ll * W_STRIDE; (void)wl;
#define DEAL(start, count) for (int gi_ = (start) + (((F.bid - (start)) % F.G) + F.G) % F.G, u = gi_ - (start); gi_ < (start) + (count); gi_ += F.G, u += F.G)
#ifndef DIS_U_AS
            DEAL(0, 192) attn_sample_unit(args, F, ll, u);
#endif
#ifndef DIS_U_AP
            DEAL(192, 1152) attn_prompt_unit(F, u);
#endif
#ifndef DIS_U_S1
            DEAL(1344, 192) s5_pass1_task(F, ll, u / 3, 8 * (u % 3) + F.wave);
#endif
#ifndef DIS_U_SG
            DEAL(1536, 128) sgu_prompt_unit(args, F, ll, u);
#endif
#ifndef DIS_U_SS
            DEAL(1664, 32) s5_sample_unit(args, F, ll, u);
#endif
#ifndef DIS_U_GS
            DEAL(1696, 32) sgu_sample_unit(args, F, ll, u);
#endif
#undef DEAL
        }
#endif
        SEAM(pb + 1);
#ifndef DIS_P3
        if (IN(pb + 2)) { const int ll = launder_i(l); unsigned char* wl = F.ws + WS_W + (size_t)ll * W_STRIDE; (void)wl;
#ifndef DIS_U_S2
            for (int u = F.bid; u < 256; u += F.G) s5_pass2_unit(args, F, ll, u);
#endif
#ifndef DIS_U_MG
            attn_merge(F);
#endif
        }
#endif
        SEAM(pb + 2);
#ifndef DIS_G4
        if (IN(pb + 3)) { const int ll = launder_i(l); unsigned char* wl = F.ws + WS_W + (size_t)ll * W_STRIDE; (void)wl;
            pg8::Gemm g{(const bf16*)(F.ws + WS_MIX), (const bf16*)(wl + W_OUT), MR, DM, DM}; pg8::StaticOrder S; S.init(MR, DM, launder_i(F.G), launder_i(F.bid));
            EpiRes E{args.in[0], args.in[1], (float*)(F.ws + WS_X), (bf16*)(F.ws + WS_XB), (float*)(F.ws + WS_RSS), ll == 0 ? 1 : 0};
            pg8::gemm_phase<EpiRes, pg8::StaticOrder, true, true>(F.lds, g, S, E, launder_i(F.wave));
        }
#endif
        SEAM(pb + 3);
#ifndef DIS_G5
        if (IN(pb + 4)) { const int ll = launder_i(l); unsigned char* wl = F.ws + WS_W + (size_t)ll * W_STRIDE; (void)wl;
            pg8::Gemm g{(const bf16*)(F.ws + WS_XB), (const bf16*)(wl + W_UP), MR, DFF2, DM}; pg8::StaticOrder S; S.init(MR, DFF2, launder_i(F.G), launder_i(F.bid));
            EpiUp E{(bf16*)(F.ws + WS_HB), (const float*)(F.ws + WS_RSS), F.out, ll};
            pg8::gemm_phase<EpiUp, pg8::StaticOrder, true, true>(F.lds, g, S, E, launder_i(F.wave));
        }
#endif
        SEAM(pb + 4);
#ifndef DIS_CV
        if (IN(pb + 5)) { const int ll = launder_i(l); unsigned char* wl = F.ws + WS_W + (size_t)ll * W_STRIDE; (void)wl; conv_gate(args, F, ll); }
#endif
        SEAM(pb + 5);
#ifndef DIS_G6
        if (IN(pb + 6)) { const int ll = launder_i(l); unsigned char* wl = F.ws + WS_W + (size_t)ll * W_STRIDE; (void)wl;
            pg8::Gemm g{(const bf16*)(F.ws + WS_A2), (const bf16*)(wl + W_DOWN), MR, DM, DFF}; pg8::StaticOrder S; S.init(MR, DM, launder_i(F.G), launder_i(F.bid));
            EpiRes E{args.in[0], args.in[1], (float*)(F.ws + WS_X), (bf16*)(F.ws + WS_XB), (float*)(F.ws + WS_RSS), 0};
            pg8::gemm_phase<EpiRes, pg8::StaticOrder, true, true>(F.lds, g, S, E, launder_i(F.wave));
        }
#endif
        SEAM(pb + 6);
    }
    if (IN(29)) { final_norm(args, F); }
#undef IN
#undef SEAM
}

#ifndef MK_SPLIT
#define MK_SPLIT 0
#endif
extern "C" void kernel_launch(void* const* d_in, const int* in_sizes, int n_in, void* d_out, int out_size, void* d_ws, size_t ws_size, hipStream_t stream) {
    static int grid = 0;
    if (grid == 0) {
        if (n_in != 28 || (size_t)out_size != OUT_END || ws_size < WS_END) { fprintf(stderr, "kernel_launch: unexpected shapes: n_in %d out %d (want %zu) ws %zu (want %zu)\n", n_in, out_size, (size_t)OUT_END, ws_size, (size_t)WS_END); grid = -1; return; }
        int dev = 0, cus = 0, per_cu = 0;
        if (hipGetDevice(&dev) != hipSuccess || hipDeviceGetAttribute(&cus, hipDeviceAttributeMultiprocessorCount, dev) != hipSuccess) { grid = -1; return; }
        if (hipFuncSetAttribute((const void*)hymba_fwd, hipFuncAttributeMaxDynamicSharedMemorySize, LDS_BYTES) != hipSuccess) { fprintf(stderr, "kernel_launch: hipFuncSetAttribute failed\n"); grid = -1; return; }
        if (hipOccupancyMaxActiveBlocksPerMultiprocessor(&per_cu, (const void*)hymba_fwd, NTHR, LDS_BYTES) != hipSuccess || per_cu < 1) { fprintf(stderr, "kernel_launch: occupancy query says %d\n", per_cu); }
        (void)hipGetLastError();
        grid = cus;
    }
    if (grid < 0) return;
    (void)hipMemsetAsync((char*)d_ws + WS_CTL, 0, CTL_ZERO_BYTES, stream);
    Args a{};
    for (int i = 0; i < 28; ++i) a.in[i] = (const float*)d_in[i];
    a.out = (float*)d_out; a.ws = (unsigned char*)d_ws;
#if MK_SPLIT
    for (int p = 0; p < N_PHASES; ++p) { a.ph_lo = p; a.ph_hi = p + 1; hipLaunchKernelGGL(hymba_fwd, dim3(grid), dim3(NTHR), LDS_BYTES, stream, a); }
#else
    a.ph_lo = 0; a.ph_hi = N_PHASES;
    hipLaunchKernelGGL(hymba_fwd, dim3(grid), dim3(NTHR), LDS_BYTES, stream, a);
#endif
}
```

```cpp
#include <hip/hip_runtime.h>
#include <cstdio>
#include <cstdint>

namespace pg8 {
#define PG8_LAS __attribute__((address_space(3)))
typedef unsigned short bf16_t;
typedef short bf16x8 __attribute__((ext_vector_type(8)));
typedef float f32x4 __attribute__((ext_vector_type(4)));
typedef unsigned u32x4 __attribute__((ext_vector_type(4)));
constexpr int BM = 256, BK = 64, HALF = 128, HTB = HALF * BK * 2  , STAGE_BYTES = 8 * HTB, NXCD = 8, WGM = 8;

__host__ __device__ __forceinline__ int lds_byte(int r, int c) { const int st = (r >> 4) * 2 + (c >> 5), rr = r & 15, cc = c & 31, ob = rr * 64 + cc * 2; return st * 1024 + (ob ^ (((ob >> 9) & 1) << 5)); }
__host__ __device__ __forceinline__ void stage_rc(int b, int& R, int& C) { const int st = b / 1024, sb = b % 1024, swz = sb ^ (((sb >> 9) & 1) << 5); R = (st >> 1) * 16 + swz / 64; C = (st & 1) * 32 + (swz % 64) / 2; }
__host__ __device__ __forceinline__ int perm32(int rho) { const int n = rho >> 4, i = rho & 15; return 8 * (i >> 2) + 4 * n + (i & 3); }

struct Unit { int pm, pn; };
struct Gemm { const bf16_t* A; const bf16_t* Bt; int M, N, K; };

struct StaticOrder {
    int nM, nN, nwg, G, c;
    __host__ __device__ void init(int M, int N, int G_, int c_) { nM = M / BM; nN = N / BM; nwg = nM * nN; G = G_; c = c_; }
    __host__ __device__ bool next(int i, Unit& u) const {
        const long L = (long)i * G + c; if (L >= nwg) return false;
        int wgid = (int)L; { const int q = nwg / NXCD, r = nwg % NXCD, xcd = wgid % NXCD, off = wgid / NXCD; wgid = (xcd < r ? xcd * (q + 1) : r * (q + 1) + (xcd - r) * q) + off; }
        const int nig = WGM * nN, gid = wgid / nig, fm = gid * WGM, gsz = (nM - fm) < WGM ? (nM - fm) : WGM;
        u.pm = fm + ((wgid % nig) % gsz); u.pn = (wgid % nig) / gsz; return true;
    }
    __device__ __forceinline__ long a_off(const Unit& u, long tstep) const { return (long)u.pm * tstep; }
    __device__ __forceinline__ void a_ready(const Unit&) const {}
    __device__ __forceinline__ void done(const Unit&) const {}
};

__device__ __forceinline__ unsigned cvt_pk_bf16(float lo, float hi) { unsigned r; asm volatile("v_cvt_pk_bf16_f32 %0, %1, %2" : "=v"(r) : "v"(lo), "v"(hi)); return r; }
typedef float f32x2 __attribute__((ext_vector_type(2)));
__device__ __forceinline__ f32x2 gelu_pk(f32x2 v) {
    const f32x2 av = __builtin_elementwise_abs(v), d = av * 0.2316418882f + 1.0f;
    f32x2 t; t.x = __builtin_amdgcn_rcpf(d.x); t.y = __builtin_amdgcn_rcpf(d.y);
    f32x2 q = t * 0.5307027145f + (-0.7265760135f); q = q * t + 0.7107068705f; q = q * t + (-0.142248368f); q = q * t + 0.127414796f; q = q * t;
    const f32x2 s = (v * v) * (-0.72134752044f);
    f32x2 e; e.x = __builtin_amdgcn_exp2f(s.x); e.y = __builtin_amdgcn_exp2f(s.y);
    const f32x2 m = v * (q * e), r = v - m;
    f32x2 o; o.x = v.x < 0.f ? m.x : r.x; o.y = v.y < 0.f ? m.y : r.y; return o;
}

template <class Epi, class Sched, bool ALIGN_EPI = false, bool SP2 = false>
__device__ __forceinline__ void gemm_phase(PG8_LAS unsigned char* lds, const Gemm g, const Sched& S, const Epi& E, const int wid_in) {
    int lane_ = (int)__builtin_amdgcn_mbcnt_hi(~0u, __builtin_amdgcn_mbcnt_lo(~0u, 0u)); asm volatile("" : "+v"(lane_));
    const int wid = wid_in, lane = lane_, tid = wid * 64 + lane, wr = wid >> 2, wc = wid & 3, fr = lane & 15, fq = lane >> 4;
    const int K = g.K, nt = K / BK;
    unsigned voffA[2], voffB[2];
#pragma unroll
    for (int i = 0; i < 2; ++i) { int R, C; stage_rc(tid * 16 + i * 8192, R, C); const int Rb = Epi::PERM ? ((R & ~31) + perm32(R & 31)) : R;
        const int Ra = Epi::APERM ? ((R & ~63) | (4 * (R & 15) + ((R >> 4) & 3))) : R;
        voffA[i] = (unsigned)(Ra * K + C) * 2u; voffB[i] = (unsigned)(Rb * K + C) * 2u; }
    const size_t kstep = (size_t)(BK * 2);
    const size_t hstep = (size_t)HALF * K * 2;
    const size_t tstep = 2 * hstep;
    const unsigned ldsw = (unsigned)wid * 1024u;
    const int aoff = lds_byte(wr * 64 + fr, fq * 8), boff = lds_byte(wc * 32 + fr, fq * 8);
#define PG8_SA(b, h) (((b) * 2 + (h)) * HTB)
#define PG8_SB(b, h) ((4 + (b) * 2 + (h)) * HTB)
#define PG8_STAGE(bufoff, gbase, voff) do { _Pragma("unroll") for (int _i = 0; _i < 2; ++_i) \
        __builtin_amdgcn_global_load_lds((const unsigned*)((const char*)(gbase) + (voff)[_i]), (PG8_LAS unsigned*)(lds + (bufoff) + ldsw + _i * 8192), 16, 0, 0); } while (0)
#define PG8_LDA(dst, b, h) do { _Pragma("unroll") for (int m = 0; m < 4; ++m) _Pragma("unroll") for (int k = 0; k < 2; ++k) dst[m][k] = *(const PG8_LAS bf16x8*)(lds + PG8_SA(b, h) + aoff + m * 2048 + k * 1024); } while (0)
#define PG8_LDB(dst, b, h) do { _Pragma("unroll") for (int n = 0; n < 2; ++n) _Pragma("unroll") for (int k = 0; k < 2; ++k) dst[n][k] = *(const PG8_LAS bf16x8*)(lds + PG8_SB(b, h) + boff + n * 2048 + k * 1024); } while (0)
#define PG8_MMA(ai, bj, At, Bt) do { __builtin_amdgcn_s_setprio(1); _Pragma("unroll") for (int m = 0; m < 4; ++m) _Pragma("unroll") for (int n = 0; n < 2; ++n) _Pragma("unroll") for (int k = 0; k < 2; ++k) \
        acc[ai][bj][m][n] = __builtin_amdgcn_mfma_f32_16x16x32_bf16(Bt[n][k], At[m][k], acc[ai][bj][m][n], 0, 0, 0); __builtin_amdgcn_s_setprio(0); } while (0)
#define PG8_WAIT_V(n) asm volatile("s_waitcnt vmcnt(" #n ")" ::: "memory")
#define PG8_WAIT_L(n) asm volatile("s_waitcnt lgkmcnt(" #n ")" ::: "memory")
#define PG8_BAR __builtin_amdgcn_s_barrier()
#define PG8_SCHED __builtin_amdgcn_sched_barrier(0)
    Unit cur, nxt; int ui = 0;
    if (!S.next(0, cur)) return;
    f32x4 acc[2][2][4][2];
#pragma unroll
    for (int a = 0; a < 2; ++a)
#pragma unroll
        for (int b = 0; b < 2; ++b)
#pragma unroll
            for (int m = 0; m < 4; ++m)
#pragma unroll
                for (int n = 0; n < 2; ++n) acc[a][b][m][n] = (f32x4){0.f, 0.f, 0.f, 0.f};
    bf16x8 At[4][2], B0[2][2], B1[2][2];
    const char* cA = (const char*)g.A + S.a_off(cur, (long)tstep); const char* cB = (const char*)g.Bt + (size_t)cur.pn * tstep;
    S.a_ready(cur);
    if constexpr (SP2) {
        PG8_STAGE(PG8_SB(0, 0), cB, voffB); PG8_STAGE(PG8_SB(0, 1), cB + hstep, voffB); PG8_STAGE(PG8_SA(0, 0), cA, voffA); PG8_STAGE(PG8_SA(0, 1), cA + hstep, voffA);
        if (wr == 1) PG8_BAR;
        PG8_WAIT_V(2); PG8_BAR;
        PG8_STAGE(PG8_SB(1, 0), cB + kstep, voffB); PG8_STAGE(PG8_SA(1, 0), cA + kstep, voffA); PG8_STAGE(PG8_SB(1, 1), cB + hstep + kstep, voffB);
        PG8_WAIT_V(6); PG8_BAR;
    } else {
        PG8_STAGE(PG8_SB(0, 0), cB, voffB); PG8_STAGE(PG8_SA(0, 0), cA, voffA); PG8_STAGE(PG8_SB(0, 1), cB + hstep, voffB); PG8_STAGE(PG8_SA(0, 1), cA + hstep, voffA);
        if (wr == 1) PG8_BAR;
        PG8_WAIT_V(4); PG8_BAR;
        PG8_STAGE(PG8_SB(1, 0), cB + kstep, voffB); PG8_STAGE(PG8_SA(1, 0), cA + kstep, voffA); PG8_STAGE(PG8_SB(1, 1), cB + hstep + kstep, voffB);
        PG8_WAIT_V(6); PG8_BAR;
    }
    for (;;) {
        const bool has_next = S.next(ui + 1, nxt);
        const char* nA = has_next ? (const char*)g.A + S.a_off(nxt, (long)tstep) : cA; const char* nB = has_next ? (const char*)g.Bt + (size_t)nxt.pn * tstep : cB;
        for (int t = 0; t < nt; t += 2) {
            const bool last = (t == nt - 2);
            const char* a1 = cA + (size_t)(t + 1) * kstep;
            const char* a2 = last ? nA : cA + (size_t)(t + 2) * kstep; const char* b2 = last ? nB : cB + (size_t)(t + 2) * kstep;
            const char* a3 = a2 + kstep; const char* b3 = b2 + kstep;
            if (last && has_next) S.a_ready(nxt);
            if constexpr (SP2) {
            PG8_LDB(B0, 0, 0); PG8_LDB(B1, 0, 1); PG8_SCHED; PG8_LDA(At, 0, 0); PG8_STAGE(PG8_SA(1, 1), a1 + hstep, voffA);
            PG8_WAIT_V(8); PG8_WAIT_L(0); PG8_BAR; PG8_MMA(0, 0, At, B0); PG8_MMA(0, 1, At, B1); PG8_BAR; PG8_SCHED;
            PG8_LDA(At, 0, 1); PG8_STAGE(PG8_SB(0, 0), b2, voffB); PG8_STAGE(PG8_SB(0, 1), b2 + hstep, voffB); PG8_STAGE(PG8_SA(0, 0), a2, voffA);
            PG8_WAIT_V(8); PG8_WAIT_L(0); PG8_BAR; PG8_MMA(1, 0, At, B0); PG8_MMA(1, 1, At, B1); PG8_BAR; PG8_SCHED;
            PG8_LDB(B0, 1, 0); PG8_LDB(B1, 1, 1); PG8_SCHED; PG8_LDA(At, 1, 0); PG8_STAGE(PG8_SA(0, 1), a2 + hstep, voffA);
            PG8_WAIT_V(8); PG8_WAIT_L(0); PG8_BAR; PG8_MMA(0, 0, At, B0); PG8_MMA(0, 1, At, B1); PG8_BAR; PG8_SCHED;
            PG8_LDA(At, 1, 1); PG8_STAGE(PG8_SB(1, 0), b3, voffB); PG8_STAGE(PG8_SB(1, 1), b3 + hstep, voffB); PG8_STAGE(PG8_SA(1, 0), a3, voffA);
            PG8_WAIT_V(8); PG8_WAIT_L(0); PG8_BAR; PG8_MMA(1, 0, At, B0); PG8_MMA(1, 1, At, B1); PG8_BAR; PG8_SCHED;
            } else {
            PG8_LDB(B0, 0, 0); PG8_SCHED; PG8_LDA(At, 0, 0); PG8_STAGE(PG8_SA(1, 1), a1 + hstep, voffA);
            PG8_WAIT_L(8); PG8_BAR; PG8_WAIT_L(0); PG8_MMA(0, 0, At, B0); PG8_BAR; PG8_SCHED;
            PG8_LDB(B1, 0, 1); PG8_STAGE(PG8_SB(0, 0), b2, voffB);
            PG8_BAR; PG8_WAIT_L(0); PG8_MMA(0, 1, At, B1); PG8_BAR;
            PG8_LDA(At, 0, 1); PG8_STAGE(PG8_SA(0, 0), a2, voffA);
            PG8_BAR; PG8_WAIT_L(0); PG8_MMA(1, 0, At, B0); PG8_BAR; PG8_SCHED;
            PG8_STAGE(PG8_SB(0, 1), b2 + hstep, voffB);
            PG8_WAIT_V(6); PG8_BAR; PG8_MMA(1, 1, At, B1); PG8_BAR;
            PG8_LDB(B0, 1, 0); PG8_SCHED; PG8_LDA(At, 1, 0); PG8_STAGE(PG8_SA(0, 1), a2 + hstep, voffA);
            PG8_WAIT_L(8); PG8_BAR; PG8_WAIT_L(0); PG8_MMA(0, 0, At, B0); PG8_BAR; PG8_SCHED;
            PG8_LDB(B1, 1, 1); PG8_STAGE(PG8_SB(1, 0), b3, voffB);
            PG8_BAR; PG8_WAIT_L(0); PG8_MMA(0, 1, At, B1); PG8_BAR;
            PG8_LDA(At, 1, 1); PG8_STAGE(PG8_SA(1, 0), a3, voffA);
            PG8_BAR; PG8_WAIT_L(0); PG8_MMA(1, 0, At, B0); PG8_BAR; PG8_SCHED;
            PG8_STAGE(PG8_SB(1, 1), b3 + hstep, voffB);
            PG8_WAIT_V(6); PG8_BAR; PG8_MMA(1, 1, At, B1); PG8_BAR;
            }
        }
        if constexpr (ALIGN_EPI) { if (wr == 0) PG8_BAR; }
        if constexpr (!Epi::AFTER_DRAIN) { E(acc, cur, wr, wc, fr, fq, ui); S.done(cur); }
        if (!has_next) break;
#pragma unroll
        for (int a = 0; a < 2; ++a)
#pragma unroll
            for (int b = 0; b < 2; ++b)
#pragma unroll
                for (int m = 0; m < 4; ++m)
#pragma unroll
                    for (int n = 0; n < 2; ++n) acc[a][b][m][n] = (f32x4){0.f, 0.f, 0.f, 0.f};
        cur = nxt; cA = nA; cB = nB; ++ui;
        if constexpr (ALIGN_EPI) { if (wr == 1) PG8_BAR; }
    }
    PG8_WAIT_V(0);
    if constexpr (!ALIGN_EPI) { if (wr == 0) PG8_BAR; }
    PG8_BAR;
    if constexpr (Epi::AFTER_DRAIN) { E.fused(acc, cur, wr, wc, fr, fq, lds, wid, lane); S.done(cur); }
#undef PG8_SA
#undef PG8_SB
#undef PG8_STAGE
#undef PG8_LDA
#undef PG8_LDB
#undef PG8_MMA
#undef PG8_WAIT_V
#undef PG8_WAIT_L
#undef PG8_BAR
#undef PG8_SCHED
}
}
#define GAS __attribute__((address_space(1)))
#define LAS __attribute__((address_space(3)))
typedef unsigned short bf16;
typedef unsigned v4u __attribute__((ext_vector_type(4)));
typedef float f32x4 __attribute__((ext_vector_type(4)));
typedef short bf16x8 __attribute__((ext_vector_type(8)));
typedef GAS unsigned gu32;
typedef GAS unsigned long long gu64;
#define RLX_AGENT __ATOMIC_RELAXED, __HIP_MEMORY_SCOPE_AGENT
#define LDS_WAIT() asm volatile("s_waitcnt lgkmcnt(0)" ::: "memory")
#define VM_WAIT() asm volatile("s_waitcnt vmcnt(0)" ::: "memory")
__device__ __forceinline__ unsigned long long rt() { return __builtin_amdgcn_s_memrealtime(); }
__device__ __forceinline__ unsigned f2bf(float f) { unsigned u = __builtin_bit_cast(unsigned, f); return (u + 0x7fffu + ((u >> 16) & 1u)) >> 16; }
__device__ __forceinline__ unsigned pk2(float lo, float hi) { return f2bf(lo) | (f2bf(hi) << 16); }

#define XB_TMO      128
#define XB_XCNT(j)  (256  + 64 * (j))
#define XB_XSUB(j)  (1280 + 64 * (j))
#define XB_XGEN(j)  (2304 + 64 * (j))
#define XB_TOP      3328
#define XB_TOPGEN   3392
#define XCD_BAR_WORDS 3456
#define XB_SPIN_CAP (1u << 18)

__device__ __forceinline__ unsigned xb_ld(unsigned* p)              { return __hip_atomic_load(p, __ATOMIC_RELAXED, __HIP_MEMORY_SCOPE_AGENT); }
__device__ __forceinline__ unsigned xb_add(unsigned* p, unsigned v) { return __hip_atomic_fetch_add(p, v, __ATOMIC_RELAXED, __HIP_MEMORY_SCOPE_AGENT); }
__device__ __forceinline__ unsigned xb_xcc_id() { return (unsigned)__builtin_amdgcn_s_getreg((3 << 11) | 20) & 0xFu; }
#define XB_SPIN(cond, bar) do { unsigned _sp = 0; while (cond) { __builtin_amdgcn_s_sleep(1); \
    if ((++_sp & 255u) == 0u) { if (xb_ld(&(bar)[XB_TMO])) break; if (_sp > XB_SPIN_CAP) { atomicAdd(&(bar)[XB_TMO], 1u); break; } } } } while (0)

struct XcdBarrier {
    unsigned* bar; unsigned x;
    volatile LAS unsigned* st;
};

__device__ __forceinline__ XcdBarrier xcd_barrier_post(unsigned* bar, volatile LAS unsigned* st) {
    XcdBarrier b; b.bar = bar; b.x = xb_xcc_id(); b.st = st;
    if (threadIdx.x == 0) (void)xb_add(&bar[XB_XCNT(b.x)], 1u);
    return b;
}
__device__ __forceinline__ void xcd_barrier_complete(unsigned* bar, unsigned x, unsigned& nloc, unsigned& nx) {
    const unsigned G = gridDim.x * gridDim.y * gridDim.z;
    unsigned sum, cnt, mine, sp = 0u;
    for (;;) {
        sum = 0u; cnt = 0u; mine = 0u;
#pragma unroll
        for (unsigned j = 0; j < 16; ++j) { const unsigned c = xb_ld(&bar[XB_XCNT(j)]); sum += c; cnt += (c > 0u) ? 1u : 0u; mine = (j == x) ? c : mine; }
        if (sum == G) break;
        __builtin_amdgcn_s_sleep(1);
        if ((++sp & 255u) == 0u) { if (xb_ld(&bar[XB_TMO])) break; if (sp > XB_SPIN_CAP) { atomicAdd(&bar[XB_TMO], 1u); break; } }
    }
    nloc = mine > 0u ? mine : 1u; nx = cnt > 0u ? cnt : 1u;
}

__device__ __forceinline__ void xcd_barrier(const XcdBarrier& b) {
    asm volatile("s_waitcnt vmcnt(0)" ::: "memory");
    __syncthreads();
    if (threadIdx.x == 0) {
        unsigned* bar = b.bar;
        __builtin_amdgcn_s_waitcnt(0);
        unsigned nloc = b.st[0], nx = b.st[1];
        if (nloc == 0u) { xcd_barrier_complete(bar, b.x, nloc, nx); b.st[0] = nloc; b.st[1] = nx; }
        const unsigned old = xb_add(&bar[XB_XSUB(b.x)], 1u);
        const unsigned gen = old / nloc;
        if (old + 1u == (gen + 1u) * nloc) {
            __builtin_amdgcn_fence(__ATOMIC_RELEASE, "agent");
            asm volatile("s_waitcnt vmcnt(0)" ::: "memory");
            const unsigned og = xb_add(&bar[XB_TOP], 1u);
            const unsigned tg = og / nx;
            if (og + 1u == (tg + 1u) * nx) xb_add(&bar[XB_TOPGEN], 1u);
            else XB_SPIN(xb_ld(&bar[XB_TOPGEN]) == tg, bar);
            __builtin_amdgcn_fence(__ATOMIC_ACQUIRE, "agent");
            xb_add(&bar[XB_XGEN(b.x)], 1u);
            asm volatile("s_waitcnt vmcnt(0)" ::: "memory");
        } else {
            XB_SPIN(xb_ld(&bar[XB_XGEN(b.x)]) == gen, bar);
            __builtin_amdgcn_fence(__ATOMIC_ACQUIRE, "agent");
            asm volatile("s_waitcnt vmcnt(0)" ::: "memory");
        }
    }
    __syncthreads();
}

#define DI __device__ __forceinline__
typedef short s16x4 __attribute__((ext_vector_type(4)));
typedef float f32x16 __attribute__((ext_vector_type(16)));
typedef float f32x2 __attribute__((ext_vector_type(2)));
typedef unsigned u32x2 __attribute__((ext_vector_type(2)));
typedef unsigned u32x4 __attribute__((ext_vector_type(4)));
typedef __bf16 bf16x2_t __attribute__((ext_vector_type(2)));

constexpr int DM = 1024, NBATCH = 2, SEQ = 8192, DEPTH = 4, SBATCH = 32, STOK = 8, PAST = 8192;
constexpr int MP = NBATCH * SEQ, MS = SBATCH * STOK, MR = MP + MS;
constexpr int AW = 256, BW = 384, CWD = 384, AH = 4, CH = 6, HD = 64;
constexpr int NG = 24, NP = 64;
constexpr int DFF = 2816, DFF2 = 5632, INW = 2048;
constexpr int O_U = 0, O_V = 256, O_S5 = 512, O_Q = 896, O_K = 1280, O_VV = 1664;
constexpr int CWIN = 2048;
constexpr float EPSN = 1e-6f;
constexpr int NWAVES = 8, NTHR = 512;

constexpr size_t OUT_YP = 0;
constexpr size_t OUT_YS = OUT_YP + (size_t)MP * DM;
constexpr size_t OUT_KP = OUT_YS + (size_t)MS * DM;
constexpr size_t OUT_VP = OUT_KP + (size_t)DEPTH * NBATCH * CWIN * CWD;
constexpr size_t OUT_KS = OUT_VP + (size_t)DEPTH * NBATCH * CWIN * CWD;
constexpr size_t OUT_VS = OUT_KS + (size_t)DEPTH * SBATCH * STOK * CWD;
constexpr size_t OUT_SRP = OUT_VS + (size_t)DEPTH * SBATCH * STOK * CWD;
constexpr size_t OUT_SIP = OUT_SRP + (size_t)DEPTH * NBATCH * NG * NP;
constexpr size_t OUT_SRS = OUT_SIP + (size_t)DEPTH * NBATCH * NG * NP;
constexpr size_t OUT_SIS = OUT_SRS + (size_t)DEPTH * SBATCH * NG * NP;
constexpr size_t OUT_FCP = OUT_SIS + (size_t)DEPTH * SBATCH * NG * NP;
constexpr size_t OUT_FCS = OUT_FCP + (size_t)DEPTH * NBATCH * 2 * DFF2;
constexpr size_t OUT_SGV = OUT_FCS + (size_t)DEPTH * SBATCH * 2 * DFF2;
constexpr size_t OUT_END = OUT_SGV + (size_t)DEPTH * SBATCH * STOK * AW;

constexpr size_t MiB = 1u << 20;
constexpr size_t WS_CTL = 0, CTL_ZERO_BYTES = 1 * MiB;
constexpr size_t WS_ROPE = 1 * MiB;
constexpr size_t WS_S5P = 2 * MiB, S5P_STRIDE = 256 * 1024;
constexpr size_t S5P_BMAT = 0, S5P_CMAT = 98304, S5P_A = 196608;
constexpr size_t WS_WSM = 3 * MiB;
constexpr size_t WS_WGLU = 4 * MiB, WGLU_STRIDE = 384 * 384 * 2;
constexpr size_t WS_S5L = 8 * MiB;
constexpr size_t WS_LSE = 14 * MiB;
constexpr size_t WS_W = 16 * MiB, W_STRIDE = 23592960;
constexpr size_t W_IN = 0, W_OUT = 4 * MiB, W_UP = 6 * MiB, W_DOWN = 17 * MiB;
constexpr size_t WS_X = 106 * MiB;
constexpr size_t WS_XB = 171 * MiB;
constexpr size_t WS_PROJ = 204 * MiB;
constexpr size_t WS_MIX = 269 * MiB;
constexpr size_t WS_OP = 302 * MiB;
constexpr size_t WS_HB = 338 * MiB;
constexpr size_t WS_A2 = 517 * MiB;
constexpr size_t WS_OPS = 607 * MiB;
constexpr size_t WS_LSES = 609 * MiB;
constexpr size_t WS_GSMP = 610 * MiB;
constexpr size_t WS_RSS = 611 * MiB;
constexpr size_t WS_S5PW = 614 * MiB;
constexpr size_t WS_S5SE = 616 * MiB;
constexpr size_t WS_END = 617 * MiB;
static_assert(W_STRIDE == 4 * MiB + 2 * MiB + 11 * MiB + 5 * MiB + MiB / 2, "weights");
static_assert(WS_W + 4 * W_STRIDE <= WS_X && WS_X + (size_t)MR * DM * 4 <= WS_XB && WS_XB + (size_t)MR * DM * 2 <= WS_PROJ && WS_PROJ + (size_t)MR * INW * 2 <= WS_MIX &&
              WS_MIX + (size_t)MR * DM * 2 <= WS_OP && WS_OP + (size_t)3 * MP * CWD * 2 <= WS_HB && WS_HB + (size_t)MR * DFF2 * 2 <= WS_A2 && WS_A2 + (size_t)MR * DFF * 2 <= WS_OPS, "ws map");
static_assert(WS_S5L + (size_t)64 * 4 * 2 * 24 * 64 * 8 <= WS_LSE && WS_LSE + (size_t)3 * MP * 6 * 4 <= WS_W, "ws map 2");

constexpr int CW_Q = 16384;
constexpr int CW_BAR = 4096;

constexpr int RING_BYTES = 131072, LDSCTL_OFF = RING_BYTES, MISC_OFF = LDSCTL_OFF + 320, RSTD_OFF = LDSCTL_OFF + 1024  , LDS_BYTES = 147456;

DI float bf2f(unsigned short v) { return __uint_as_float(((unsigned)v) << 16); }
DI unsigned cvtpk(float lo, float hi) { f32x2 v = {lo, hi}; bf16x2_t b = __builtin_convertvector(v, bf16x2_t); return __builtin_bit_cast(unsigned, b); }
DI unsigned short f2bf1(float x) { return (unsigned short)(cvtpk(x, 0.f) & 0xffffu); }
DI float gelu_t(float x) {
    const float t = x * x, u = t * -0.1029432397f - 2.3022081985f;
    return x * __builtin_amdgcn_rcpf(1.0f + __builtin_amdgcn_exp2f(x * u));
}
DI float sigmoid_f(float x) { return __builtin_amdgcn_rcpf(1.0f + __builtin_amdgcn_exp2f(-1.4426950409f * x)); }
DI int crow(int reg, int h) { return (reg & 3) + 8 * (reg >> 2) + 4 * h; }
DI f32x16 mfma32(bf16x8 a, bf16x8 b, f32x16 c) { return __builtin_amdgcn_mfma_f32_32x32x16_bf16(a, b, c, 0, 0, 0); }
DI f32x16 zero16() { f32x16 z; for (int i = 0; i < 16; ++i) z[i] = 0.f; return z; }
DI float wave_sum(float v) {
    v += __builtin_bit_cast(float, __builtin_amdgcn_update_dpp(0, __builtin_bit_cast(int, v), 0x128, 0xf, 0xf, false));
    v += __builtin_bit_cast(float, __builtin_amdgcn_update_dpp(0, __builtin_bit_cast(int, v), 0x124, 0xf, 0xf, false));
    v += __builtin_bit_cast(float, __builtin_amdgcn_update_dpp(0, __builtin_bit_cast(int, v), 0x122, 0xf, 0xf, false));
    v += __builtin_bit_cast(float, __builtin_amdgcn_update_dpp(0, __builtin_bit_cast(int, v), 0x121, 0xf, 0xf, false));
    v += __shfl_xor(v, 16); v += __shfl_xor(v, 32);
    return v;
}
DI float wave_max(float v) {
#pragma unroll
    for (int o = 1; o < 64; o <<= 1) v = fmaxf(v, __shfl_xor(v, o));
    return v;
}
DI int rope_phys(int d) { return d < 8 ? 2 * d : (d < 16 ? 2 * (d - 8) + 1 : d); }
__host__ __device__ inline int rope_log(int p) { return p < 16 ? ((p & 1) ? 8 + (p >> 1) : (p >> 1)) : p; }
DI int row_pos(int row) { return row < MP ? (row & (SEQ - 1)) : PAST + ((row - MP) & (STOK - 1)); }

struct Args { const float* in[28]; float* out; unsigned char* ws; int ph_lo, ph_hi; };
struct Frame {
    LAS unsigned char* lds;
    int tid, lane, wave, G, bid;
    float* out;
    unsigned char* ws;
};
#define FIN(k) (args.in[k])
DI void launder(Frame& F) { asm volatile("" : "+s"(F.bid), "+s"(F.G)); int ln = (int)__builtin_amdgcn_mbcnt_hi(~0u, __builtin_amdgcn_mbcnt_lo(~0u, 0u)); asm volatile("" : "+v"(ln)); F.lane = ln; F.tid = F.wave * 64 + ln; }
DI int launder_i(int x) { asm volatile("" : "+s"(x)); return x; }

DI float row_rstd(const float* rss, int row) {
    const f32x4* rp = (const f32x4*)(rss + (size_t)row * 32);
    float s = 0.f;
#pragma unroll
    for (int i = 0; i < 8; ++i) { const f32x4 a = rp[i]; s += (a.x + a.y) + (a.z + a.w); }
    return 1.0f / sqrtf(s * (1.0f / DM) + EPSN);
}
DI void store8_bf16(bf16* dst, const float (&v)[8]) {
    u32x4 w; w.x = cvtpk(v[0], v[1]); w.y = cvtpk(v[2], v[3]); w.z = cvtpk(v[4], v[5]); w.w = cvtpk(v[6], v[7]);
    *(u32x4*)dst = w;
}

template <class Sched> DI void build_rstd_table(Frame& F, const Sched& S, const float* rss) {
    LAS float* tab = (LAS float*)(F.lds + RSTD_OFF);
    pg8::Unit u;
    for (int i = 0; i < 6 && S.next(i, u); ++i) if (F.tid < 256) tab[i * 256 + F.tid] = row_rstd(rss, u.pm * 256 + F.tid);
    __syncthreads();
}

DI void epi_in_apply(int row, int c0, float (&v)[8], const f32x4 t0, const f32x4 t1, bf16* proj, float* out, int layer) {
    const int hd = (c0 - O_Q) & 63;
    if (c0 < O_S5) {
#pragma unroll
        for (int e = 0; e < 8; ++e) v[e] = gelu_t(v[e]);
    } else if (c0 >= O_Q) {
        const int head = ((c0 - O_Q) >> 6) % CH;
        const bool isk = c0 >= O_K && c0 < O_VV, isv = c0 >= O_VV;
        if (!isv && hd < 16) {
            const float cs[4] = {t0.x, t0.z, t1.x, t1.z}, sn[4] = {t0.y, t0.w, t1.y, t1.w};
#pragma unroll
            for (int j = 0; j < 4; ++j) { const float x1 = v[2 * j], x2 = v[2 * j + 1]; v[2 * j] = x1 * cs[j] - x2 * sn[j]; v[2 * j + 1] = x2 * cs[j] + x1 * sn[j]; }
        }
        if (isk || isv) {
            float* dst = nullptr;
            if (row < MP) { const int b = row >> 13, t = row & (SEQ - 1);
                if (t >= SEQ - CWIN) dst = out + (isk ? OUT_KP : OUT_VP) + ((((size_t)layer * NBATCH + b) * CWIN + (t - (SEQ - CWIN))) * CH + head) * HD;
            } else { const int rs_ = row - MP;
                dst = out + (isk ? OUT_KS : OUT_VS) + (((size_t)layer * MS + rs_) * CH + head) * HD; }
            if (dst) {
                if (isk && hd < 16) { *(f32x4*)(dst + (hd >> 1)) = (f32x4){v[0], v[2], v[4], v[6]}; *(f32x4*)(dst + 8 + (hd >> 1)) = (f32x4){v[1], v[3], v[5], v[7]}; }
                else { *(f32x4*)(dst + hd) = (f32x4){v[0], v[1], v[2], v[3]}; *(f32x4*)(dst + hd + 4) = (f32x4){v[4], v[5], v[6], v[7]}; }
            }
        }
    }
    store8_bf16(proj + (size_t)row * INW + c0, v);
}

struct EpiIn {
    static constexpr bool PERM = true, AFTER_DRAIN = false, APERM = false;
    bf16* proj; const LAS float* tab; const f32x2* rope; float* out; int layer;
    DI void operator()(const pg8::f32x4 (&acc)[2][2][4][2], const pg8::Unit& u, int wr, int wc, int fr, int fq, int ui) const {
        const int hd = (32 * wc + 8 * fq) & 63;
        const int cA = u.pn * 256 + wc * 32 + 8 * fq;
        const bool ropeA = cA >= O_Q && cA < O_VV && hd < 16, ropeB = cA + 128 >= O_Q && cA + 128 < O_VV && hd < 16;
#pragma unroll
        for (int ai = 0; ai < 2; ++ai) {
            float rs[4]; f32x4 t0[4], t1[4];
#pragma unroll
            for (int m = 0; m < 4; ++m) { rs[m] = tab[ui * 256 + ai * 128 + wr * 64 + m * 16 + fr]; t0[m] = (f32x4){1.f, 0.f, 1.f, 0.f}; t1[m] = t0[m]; }
            if (ropeA || ropeB) {
#pragma unroll
                for (int m = 0; m < 4; ++m) { const int row = u.pm * 256 + ai * 128 + wr * 64 + m * 16 + fr; const f32x4* rp = (const f32x4*)(rope + (size_t)row_pos(row) * 8 + (hd >> 1)); t0[m] = rp[0]; t1[m] = rp[1]; }
            }
#pragma unroll
            for (int m = 0; m < 4; ++m) {
                const int row = u.pm * 256 + ai * 128 + wr * 64 + m * 16 + fr;
#pragma unroll
                for (int bj = 0; bj < 2; ++bj) {
                    float v[8];
#pragma unroll
                    for (int e = 0; e < 4; ++e) { v[e] = acc[ai][bj][m][0][e] * rs[m]; v[4 + e] = acc[ai][bj][m][1][e] * rs[m]; }
                    epi_in_apply(row, cA + bj * 128, v, t0[m], t1[m], proj, out, layer);
                }
            }
            asm volatile("" ::: "memory");
        }
    }
};

struct EpiRes {
    static constexpr bool PERM = true, AFTER_DRAIN = false, APERM = false;
    const float* xp; const float* xs; float* X; bf16* XB; float* rss; int first; int dry; int wf32;
    DI void operator()(const pg8::f32x4 (&acc)[2][2][4][2], const pg8::Unit& u, int wr, int wc, int fr, int fq, int ui) const {
#pragma unroll
        for (int ai = 0; ai < 2; ++ai) {
            f32x4 xo[4][2][2];
            if (first) {
#pragma unroll
                for (int m = 0; m < 4; ++m) {
                    const int row = u.pm * 256 + ai * 128 + wr * 64 + m * 16 + fr;
                    const float* src = row < MP ? xp + (size_t)row * DM : xs + (size_t)(row - MP) * DM;
#pragma unroll
                    for (int bj = 0; bj < 2; ++bj) { const int c0 = u.pn * 256 + bj * 128 + wc * 32 + 8 * fq; xo[m][bj][0] = *(const f32x4*)(src + c0); xo[m][bj][1] = *(const f32x4*)(src + c0 + 4); }
                }
            } else {
#pragma unroll
                for (int m = 0; m < 4; ++m) {
                    const int row = u.pm * 256 + ai * 128 + wr * 64 + m * 16 + fr;
#pragma unroll
                    for (int bj = 0; bj < 2; ++bj) { const int c0 = u.pn * 256 + bj * 128 + wc * 32 + 8 * fq; const u32x4 rw = *(const u32x4*)(XB + (size_t)row * DM + c0);
                        xo[m][bj][0] = (f32x4){__uint_as_float(rw.x << 16), __uint_as_float(rw.x & 0xffff0000u), __uint_as_float(rw.y << 16), __uint_as_float(rw.y & 0xffff0000u)};
                        xo[m][bj][1] = (f32x4){__uint_as_float(rw.z << 16), __uint_as_float(rw.z & 0xffff0000u), __uint_as_float(rw.w << 16), __uint_as_float(rw.w & 0xffff0000u)}; }
                }
            }
#pragma unroll
            for (int m = 0; m < 4; ++m) {
                const int row = u.pm * 256 + ai * 128 + wr * 64 + m * 16 + fr;
                float ss = 0.f;
#pragma unroll
                for (int bj = 0; bj < 2; ++bj) {
                    const int c0 = u.pn * 256 + bj * 128 + wc * 32 + 8 * fq;
                    float v[8];
#pragma unroll
                    for (int e = 0; e < 4; ++e) { v[e] = acc[ai][bj][m][0][e] + xo[m][bj][0][e]; v[4 + e] = acc[ai][bj][m][1][e] + xo[m][bj][1][e]; }
                    if (!dry) { store8_bf16(XB + (size_t)row * DM + c0, v);
                        if (wf32) { *(f32x4*)(X + (size_t)row * DM + c0) = (f32x4){v[0], v[1], v[2], v[3]}; *(f32x4*)(X + (size_t)row * DM + c0 + 4) = (f32x4){v[4], v[5], v[6], v[7]}; } }
#pragma unroll
                    for (int e = 0; e < 8; ++e) ss += v[e] * v[e];
                }
                ss += __shfl_xor(ss, 16); ss += __shfl_xor(ss, 32);
                if (fq == 0 && !dry) rss[(size_t)row * 32 + u.pn * 4 + wc] = ss;
            }
            asm volatile("" ::: "memory");
        }
    }
};

constexpr int UP_PANELS = 66, UP_PPB = 33, UP_STEP = 254, UP_SMP = 9999;
struct UpOrder : pg8::StaticOrder {
    DI long a_off(const pg8::Unit& u, long tstep) const { const int b = u.pm / UP_PPB, p = u.pm % UP_PPB; return ((long)(u.pm == UP_SMP ? MP : b * SEQ + UP_STEP * p - 2) * (tstep >> 8)); }
};
constexpr int PAR_OFF = RSTD_OFF + 6144 + 8192;
template <class Sched> DI void build_rstd_table_up(Frame& F, const Sched& S, const float* rss, const float* cw, const float* cb) {
    LAS float* tab = (LAS float*)(F.lds + RSTD_OFF);
    pg8::Unit u;
    for (int i = 0; i < 6 && S.next(i, u); ++i) {
        if (F.tid < 256) { const int b = u.pm / UP_PPB, p = u.pm % UP_PPB, row = (u.pm == UP_SMP ? MP : b * SEQ + UP_STEP * p - 2) + F.tid; tab[i * 256 + F.tid] = (row >= 0) ? row_rstd(rss, row) : 1.0f; }
    }
    if (F.bid >= F.G - 22 && F.bid >= (UP_PANELS * 22) % F.G && (UP_PANELS * 22) % F.G > 0 && F.tid < 256) tab[5 * 256 + F.tid] = row_rstd(rss, MP + F.tid);
    __syncthreads();
}
DI float dpp_ror1(float x) { return __builtin_bit_cast(float, __builtin_amdgcn_mov_dpp(__builtin_bit_cast(int, x), 0x121, 0xf, 0xf, true)); }
DI float dpp_ror2(float x) { return __builtin_bit_cast(float, __builtin_amdgcn_mov_dpp(__builtin_bit_cast(int, x), 0x122, 0xf, 0xf, true)); }
DI float dpp_shr1_old(float old, float x) { return __builtin_bit_cast(float, __builtin_amdgcn_update_dpp(__builtin_bit_cast(int, old), __builtin_bit_cast(int, x), 0x111, 0xf, 0xf, false)); }
DI float dpp_shr2_old(float old, float x) { return __builtin_bit_cast(float, __builtin_amdgcn_update_dpp(__builtin_bit_cast(int, old), __builtin_bit_cast(int, x), 0x112, 0xf, 0xf, false)); }
DI float gelu_mul(float x, float y) {
    const float t = x * x, u = t * -0.1029432397f - 2.3022081985f, z = x * u;
    return (x * __builtin_amdgcn_rcpf(1.0f + __builtin_amdgcn_exp2f(z))) * y;
}
constexpr int XCH_OFF = RSTD_OFF + 6144;
struct EpiNull { static constexpr bool PERM = true, AFTER_DRAIN = false, APERM = false; float* sink;
    DI void operator()(pg8::f32x4 (&acc)[2][2][4][2], const pg8::Unit& u, int wr, int wc, int fr, int fq, int ui) const { float s = 0.f;
#pragma unroll
        for (int a = 0; a < 2; ++a)
#pragma unroll
            for (int b = 0; b < 2; ++b)
#pragma unroll
                for (int m = 0; m < 4; ++m)
#pragma unroll
                    for (int n = 0; n < 2; ++n) s += (acc[a][b][m][n][0] + acc[a][b][m][n][1]) + (acc[a][b][m][n][2] + acc[a][b][m][n][3]);
        if (s == 1.2345e-30f) sink[0] = 1.f; } };
constexpr int SMP_UNITS = 22;
struct SmpOrder {
    int G, c;
    DI bool next(int i, pg8::Unit& u) const { const int k = c - (G - SMP_UNITS); if (i != 0 || k < 0) return false; u.pm = 0; u.pn = k; return true; }
    DI long a_off(const pg8::Unit&, long tstep) const { return (long)MP * (tstep >> 8); }
    DI void a_ready(const pg8::Unit&) const {}
    DI void done(const pg8::Unit&) const {}
};
struct EpiUpSample {
    static constexpr bool PERM = true, AFTER_DRAIN = true, APERM = false;
    bf16* a2; LAS float* rst; const float* rss; const float* cw; const float* cb; const float* sbuf; float* out; int layer; int pre;
    DI void fused(pg8::f32x4 (&acc)[2][2][4][2], const pg8::Unit& u, int wr, int wc, int fr, int fq, PG8_LAS unsigned char* lds, int wid, int lane) const {
        const int tid = wid * 64 + lane;
        if (!pre) { if (tid < 256) rst[tid] = row_rstd(rss, MP + tid);
            asm volatile("s_waitcnt vmcnt(0) lgkmcnt(0)" ::: "memory"); __builtin_amdgcn_s_barrier(); asm volatile("" ::: "memory"); }
        const int jg = u.pn * 128 + wc * 32 + 8 * fq;
#pragma unroll
        for (int ai = 0; ai < 2; ++ai)
#pragma unroll
            for (int m = 0; m < 4; ++m) { const int r = ai * 128 + wr * 64 + m * 16 + fr, t = r & 7, sb = r >> 3; const float rs = rst[r];
#pragma unroll
                for (int bj = 0; bj < 2; ++bj) { const pg8::f32x4 v0 = acc[ai][bj][m][0] * rs, v1 = acc[ai][bj][m][1] * rs;
                    if (t >= STOK - 2) { float* sd = out + OUT_FCS + (((size_t)layer * SBATCH + sb) * 2 + (t - (STOK - 2))) * DFF2 + bj * DFF + jg; *(pg8::f32x4*)sd = v0; *(pg8::f32x4*)(sd + 4) = v1; }
                    u32x4 w; w.x = cvtpk(v0[0], v0[1]); w.y = cvtpk(v0[2], v0[3]); w.z = cvtpk(v1[0], v1[1]); w.w = cvtpk(v1[2], v1[3]);
                    const int c = bj * 16 + wc * 4 + fq; *(PG8_LAS u32x4*)(lds + (size_t)(r * 32 + (c ^ (r & 15))) * 16) = w; } }
        asm volatile("s_waitcnt lgkmcnt(0)" ::: "memory"); __builtin_amdgcn_s_barrier(); asm volatile("" ::: "memory");
        { const int cc = tid & 15, t = (tid >> 4) & 7, j0 = u.pn * 128 + 8 * cc;
          float cbv[2][8], cwv[3][2][8];
#pragma unroll
          for (int half = 0; half < 2; ++half) { const int col = half * DFF + j0;
              { const f32x4 b0 = *(const f32x4*)(cb + col), b1 = *(const f32x4*)(cb + col + 4); cbv[half][0] = b0.x; cbv[half][1] = b0.y; cbv[half][2] = b0.z; cbv[half][3] = b0.w; cbv[half][4] = b1.x; cbv[half][5] = b1.y; cbv[half][6] = b1.z; cbv[half][7] = b1.w; }
#pragma unroll
              for (int tap = 0; tap < 3; ++tap) { const f32x4 w0 = *(const f32x4*)(cw + (size_t)tap * DFF2 + col), w1 = *(const f32x4*)(cw + (size_t)tap * DFF2 + col + 4);
                  cwv[tap][half][0] = w0.x; cwv[tap][half][1] = w0.y; cwv[tap][half][2] = w0.z; cwv[tap][half][3] = w0.w; cwv[tap][half][4] = w1.x; cwv[tap][half][5] = w1.y; cwv[tap][half][6] = w1.z; cwv[tap][half][7] = w1.w; } }
#pragma unroll 2
          for (int q = 0; q < 8; ++q) { const int row = (tid >> 4) + 32 * q, sb = row >> 3;
            float hc[2][8];
#pragma unroll
            for (int half = 0; half < 2; ++half) { const int col = half * DFF + j0;
#pragma unroll
                for (int e2 = 0; e2 < 8; ++e2) hc[half][e2] = cbv[half][e2];
#pragma unroll
                for (int tap = 0; tap < 3; ++tap) { const int back = 2 - tap; float hv[8];
                    if (t - back >= 0) { const int rr = row - back, c = half * 16 + cc; const u32x4 rw = *(const PG8_LAS u32x4*)(lds + (size_t)(rr * 32 + (c ^ (rr & 15))) * 16);
#pragma unroll
                        for (int e2 = 0; e2 < 4; ++e2) { hv[2 * e2] = __uint_as_float(rw[e2] << 16); hv[2 * e2 + 1] = __uint_as_float(rw[e2] & 0xffff0000u); } }
                    else { const float* sp = sbuf + (((size_t)layer * SBATCH + sb) * 2 + (t - back + 2)) * DFF2 + col; const f32x4 s0 = *(const f32x4*)sp, s1 = *(const f32x4*)(sp + 4);
                        hv[0] = s0.x; hv[1] = s0.y; hv[2] = s0.z; hv[3] = s0.w; hv[4] = s1.x; hv[5] = s1.y; hv[6] = s1.z; hv[7] = s1.w; }
#pragma unroll
                    for (int e2 = 0; e2 < 8; ++e2) hc[half][e2] += cwv[tap][half][e2] * hv[e2]; } }
            float o[8];
#pragma unroll
            for (int e2 = 0; e2 < 8; ++e2) o[e2] = gelu_t(hc[0][e2]) * hc[1][e2];
            store8_bf16(a2 + (size_t)(MP + row) * DFF + j0, o); } }
    }
};
struct EpiStoreOnly { static constexpr bool PERM = true, AFTER_DRAIN = false, APERM = false; bf16* a2;
    DI void operator()(pg8::f32x4 (&acc)[2][2][4][2], const pg8::Unit& u, int wr, int wc, int fr, int fq, int ui) const {
        const int b = u.pm / UP_PPB, p = u.pm % UP_PPB, tbase = UP_STEP * p - 2, jg = u.pn * 128 + wc * 32 + 8 * fq;
#pragma unroll
        for (int ai = 0; ai < 2; ++ai)
#pragma unroll
            for (int m = 0; m < 4; ++m) { const int r = ai * 128 + wr * 64 + m * 16 + fr, t = tbase + r;
                if (r >= 2 && t < SEQ) { float v[8];
#pragma unroll
                    for (int e = 0; e < 4; ++e) { v[e] = acc[ai][0][m][0][e] + acc[ai][1][m][0][e]; v[4 + e] = acc[ai][0][m][1][e] + acc[ai][1][m][1][e]; }
                    store8_bf16(a2 + (size_t)(b * SEQ + t) * DFF + jg, v); } } } };
struct EpiUpConv {
    static constexpr bool PERM = true, AFTER_DRAIN = false, APERM = true;
    bf16* a2; const LAS float* tab; LAS float* xch; const float* cw; const float* cb; const float* sbuf; float* out; int layer; int mode;
    DI void operator()(pg8::f32x4 (&acc)[2][2][4][2], const pg8::Unit& u, int wr, int wc, int fr, int fq, int ui) const {
        const int b = u.pm / UP_PPB, p = u.pm % UP_PPB, tbase = UP_STEP * p - 2;
        float rs[2][4];
#pragma unroll
        for (int ai = 0; ai < 2; ++ai) { const pg8::f32x4 r4 = *(const LAS pg8::f32x4*)(tab + ui * 256 + ai * 128 + wr * 64 + 4 * fr); rs[ai][0] = r4[0]; rs[ai][1] = r4[1]; rs[ai][2] = r4[2]; rs[ai][3] = r4[3]; }
        const bool z00 = (p == 0 && wr == 0 && fr == 0);
        if (fr == 15) {
#pragma unroll
            for (int ai = 0; ai < 2; ++ai)
#pragma unroll
                for (int bj = 0; bj < 2; ++bj)
#pragma unroll
                    for (int n = 0; n < 2; ++n)
#pragma unroll
                        for (int mm = 0; mm < 2; ++mm) { pg8::f32x4 v = acc[ai][bj][2 + mm][n] * rs[ai][2 + mm];
                            *(LAS pg8::f32x4*)(xch + ((((ai * 2 + wr) * 2 + mm) * 4 + wc) * 64 + bj * 32 + 8 * fq + 4 * n)) = v; }
        }
        asm volatile("s_waitcnt lgkmcnt(0)" ::: "memory"); __builtin_amdgcn_s_barrier(); asm volatile("" ::: "memory");
        const int jg = u.pn * 128 + wc * 32 + 8 * fq;
        if (p == UP_PPB - 1) {
#pragma unroll
            for (int ai = 0; ai < 2; ++ai)
#pragma unroll
                for (int m = 0; m < 4; ++m) { const int t = tbase + ai * 128 + wr * 64 + 4 * fr + m;
                    if (t == SEQ - 2 || t == SEQ - 1) { float* sd = out + OUT_FCP + (((size_t)layer * NBATCH + b) * 2 + (t - (SEQ - 2))) * DFF2 + jg;
#pragma unroll
                        for (int bj = 0; bj < 2; ++bj)
#pragma unroll
                            for (int n = 0; n < 2; ++n) *(pg8::f32x4*)(sd + bj * DFF + 4 * n) = acc[ai][bj][m][n] * rs[ai][m]; } }
        }
#pragma unroll
        for (int n = 0; n < 2; ++n) {
            asm volatile("" ::: "memory");
            const int j4 = jg + 4 * n;
            const pg8::f32x4 cbg = *(const pg8::f32x4*)(cb + j4), cbu = *(const pg8::f32x4*)(cb + DFF + j4);
            const pg8::f32x4 w0g = *(const pg8::f32x4*)(cw + j4), w0u = *(const pg8::f32x4*)(cw + DFF + j4);
            const pg8::f32x4 w1g = *(const pg8::f32x4*)(cw + DFF2 + j4), w1u = *(const pg8::f32x4*)(cw + DFF2 + DFF + j4);
            const pg8::f32x4 w2g = *(const pg8::f32x4*)(cw + 2 * DFF2 + j4), w2u = *(const pg8::f32x4*)(cw + 2 * DFF2 + DFF + j4);
#pragma unroll
            for (int ep = 0; ep < 2; ++ep) {
                const f32x2 cbg2 = {cbg[2 * ep], cbg[2 * ep + 1]}, cbu2 = {cbu[2 * ep], cbu[2 * ep + 1]};
                const f32x2 w0g2 = {w0g[2 * ep], w0g[2 * ep + 1]}, w0u2 = {w0u[2 * ep], w0u[2 * ep + 1]}, w1g2 = {w1g[2 * ep], w1g[2 * ep + 1]}, w1u2 = {w1u[2 * ep], w1u[2 * ep + 1]};
                const f32x2 w2g2 = {w2g[2 * ep], w2g[2 * ep + 1]}, w2u2 = {w2u[2 * ep], w2u[2 * ep + 1]};
#pragma unroll
                for (int ai = 0; ai < 2; ++ai) {
                    asm volatile("" ::: "memory");
                    f32x2 x0g, x1g, x0u, x1u;
                    { const int pa = (ai + wr == 2) ? 1 : 0, pw = (ai == 1 && wr == 0) ? 1 : 0;
                        const LAS float* xb = xch + (((pa * 2 + pw) * 2) * 4 + wc) * 64 + 8 * fq + 4 * n + 2 * ep;
                        x0g = *(const LAS f32x2*)(xb); x0u = *(const LAS f32x2*)(xb + 32); x1g = *(const LAS f32x2*)(xb + 256); x1u = *(const LAS f32x2*)(xb + 256 + 32); }
                    f32x2 hg[4], hu[4];
#pragma unroll
                    for (int m = 0; m < 4; ++m) { hg[m] = (f32x2){acc[ai][0][m][n][2 * ep], acc[ai][0][m][n][2 * ep + 1]} * rs[ai][m]; hu[m] = (f32x2){acc[ai][1][m][n][2 * ep], acc[ai][1][m][n][2 * ep + 1]} * rs[ai][m]; }
                    if (ai == 0 && z00) { hg[0] = (f32x2){0.f, 0.f}; hu[0] = (f32x2){0.f, 0.f}; hg[1] = (f32x2){0.f, 0.f}; hu[1] = (f32x2){0.f, 0.f}; }
#pragma unroll
                    for (int m = 0; m < 4; ++m) asm volatile("" : "+v"(hg[m].x), "+v"(hg[m].y), "+v"(hu[m].x), "+v"(hu[m].y));
                    const f32x2 s3g = {dpp_shr1_old(x1g.x, hg[3].x), dpp_shr1_old(x1g.y, hg[3].y)}, s2g = {dpp_shr1_old(x0g.x, hg[2].x), dpp_shr1_old(x0g.y, hg[2].y)};
                    const f32x2 s3u = {dpp_shr1_old(x1u.x, hu[3].x), dpp_shr1_old(x1u.y, hu[3].y)}, s2u = {dpp_shr1_old(x0u.x, hu[2].x), dpp_shr1_old(x0u.y, hu[2].y)};
                    f32x2 ares[4];
#pragma unroll
                    for (int m = 0; m < 4; ++m) {
                        const f32x2 h1g = m == 0 ? s3g : hg[m - 1], h2g = m == 0 ? s2g : (m == 1 ? s3g : hg[m - 2]);
                        const f32x2 h1u = m == 0 ? s3u : hu[m - 1], h2u = m == 0 ? s2u : (m == 1 ? s3u : hu[m - 2]);
                        const f32x2 hcg = cbg2 + w0g2 * h2g + w1g2 * h1g + w2g2 * hg[m], hcu = cbu2 + w0u2 * h2u + w1u2 * h1u + w2u2 * hu[m];
                        const f32x2 t = hcg * hcg, uq = t * -0.1029432397f - 2.3022081985f, z = hcg * uq;
                        f32x2 ex; ex.x = __builtin_amdgcn_exp2f(z.x); ex.y = __builtin_amdgcn_exp2f(z.y);
                        const f32x2 dn = ex + 1.0f; f32x2 rc; rc.x = __builtin_amdgcn_rcpf(dn.x); rc.y = __builtin_amdgcn_rcpf(dn.y);
                        ares[m] = (hcg * rc) * hcu;
                    }
#pragma unroll
                    for (int m = 0; m < 4; ++m) asm volatile("" : "+v"(ares[m].x), "+v"(ares[m].y));
#pragma unroll
                    for (int m = 0; m < 4; ++m) { acc[ai][0][m][n][2 * ep] = ares[m].x; acc[ai][0][m][n][2 * ep + 1] = ares[m].y; }
                }
            }
        }
#pragma unroll
        for (int ai = 0; ai < 2; ++ai)
#pragma unroll
            for (int m = 0; m < 4; ++m) { const int r = ai * 128 + wr * 64 + 4 * fr + m, t = tbase + r;
                if (r >= 2 && t < SEQ && (mode == 0 || acc[ai][0][m][0][0] == 1.2345e-30f)) { float v[8];
#pragma unroll
                    for (int e = 0; e < 4; ++e) { v[e] = acc[ai][0][m][0][e]; v[4 + e] = acc[ai][0][m][1][e]; }
                    store8_bf16(a2 + (size_t)(b * SEQ + t) * DFF + jg, v); } }
    }
};

template <int MODE> DI int wrow_map(int n) {
    if (MODE == 1) { if (n >= O_Q && n < O_VV) { const int dl = (n - O_Q) & 63; return n - dl + rope_phys(dl); } return n; }
    if (MODE == 2) { const int bj = n >= DFF ? 1 : 0, j = n - bj * DFF; return 256 * (j >> 7) + 128 * bj + (j & 127); }
    return n;
}
template <int MODE, bool GAIN> DI void transpose_item(const float* W, int K, int N, bf16* WT, LAS float* scr, int item, int lane, const float* gain) {
    const int nblk = N / 32, kb = item / nblk, nb = item % nblk, k0 = 64 * kb, n0 = 32 * nb;
    float wv[32];
#pragma unroll
    for (int i = 0; i < 32; ++i) { const int kk = 2 * i + (lane >> 5); wv[i] = W[(size_t)(k0 + kk) * N + n0 + (lane & 31)]; }
    const int c = lane & 7;
    f32x4 g0 = (f32x4){1.f, 1.f, 1.f, 1.f}, g1 = g0;
    if (GAIN) { g0 = *(const f32x4*)(gain + k0 + 8 * c); g1 = *(const f32x4*)(gain + k0 + 8 * c + 4); }
#pragma unroll
    for (int i = 0; i < 32; ++i) { const int kk = 2 * i + (lane >> 5); scr[kk * 33 + (lane & 31)] = wv[i]; }
    LDS_WAIT(); asm volatile("" ::: "memory");
#pragma unroll
    for (int j = 0; j < 4; ++j) { const int n = (lane >> 3) + 8 * j; const LAS float* s = scr + (8 * c) * 33 + n;
        u32x4 o; o.x = cvtpk(s[0 * 33] * g0.x, s[1 * 33] * g0.y); o.y = cvtpk(s[2 * 33] * g0.z, s[3 * 33] * g0.w); o.z = cvtpk(s[4 * 33] * g1.x, s[5 * 33] * g1.y); o.w = cvtpk(s[6 * 33] * g1.z, s[7 * 33] * g1.w);
        *(u32x4*)(WT + (size_t)wrow_map<MODE>(n0 + n) * K + k0 + 8 * c) = o; }
    LDS_WAIT(); asm volatile("" ::: "memory");
}

DI void convert_layer_weights(const Args& args, Frame& F, int l, int first_block, int nblocks) {
    launder(F);
    LAS float* scr = (LAS float*)(F.lds + F.wave * 16384);
    const int gw = (F.bid - first_block) * NWAVES + F.wave, NGW = nblocks * NWAVES;
    constexpr int I_IN = (DM / 64) * (INW / 32), I_OUT = (DM / 64) * (DM / 32), I_UP = (DM / 64) * (DFF2 / 32), I_DN = (DFF / 64) * (DM / 32), I_GL = (BW / 64) * (BW / 32);
    constexpr int I_L = I_IN + I_OUT + I_UP + I_DN + I_GL;
    bf16* wl = (bf16*)(F.ws + WS_W + (size_t)l * W_STRIDE);
    for (int it = gw; it < I_L; it += NGW) {
        int r = it;
        if (r < I_IN) { transpose_item<1, true>(args.in[8] + (size_t)l * DM * INW, DM, INW, (bf16*)((unsigned char*)wl + W_IN), scr, r, F.lane, args.in[7] + l * DM); continue; } r -= I_IN;
        if (r < I_OUT) { transpose_item<0, false>(args.in[21] + (size_t)l * DM * DM, DM, DM, (bf16*)((unsigned char*)wl + W_OUT), scr, r, F.lane, nullptr); continue; } r -= I_OUT;
        if (r < I_UP) { transpose_item<2, true>(args.in[23] + (size_t)l * DM * DFF2, DM, DFF2, (bf16*)((unsigned char*)wl + W_UP), scr, r, F.lane, args.in[22] + l * DM); continue; } r -= I_UP;
        if (r < I_DN) { transpose_item<0, false>(args.in[26] + (size_t)l * DFF * DM, DFF, DM, (bf16*)((unsigned char*)wl + W_DOWN), scr, r, F.lane, nullptr); continue; } r -= I_DN;
        transpose_item<0, false>(args.in[19] + (size_t)l * BW * BW, BW, BW, (bf16*)(F.ws + WS_WGLU + (size_t)l * WGLU_STRIDE), scr, r, F.lane, nullptr);
    }
}

DI void prologue(const Args& args, Frame& F) {
    launder(F);
    LAS float* scr = (LAS float*)(F.lds + F.wave * 16384);
    const int gw = F.bid * NWAVES + F.wave, NGW = F.G * NWAVES;
    const int gt = F.bid * NTHR + F.tid, NGT = F.G * NTHR;
    convert_layer_weights(args, F, 0, 0, F.G);
    { bf16* wsm = (bf16*)(F.ws + WS_WSM); const float* ws_ = args.in[9];
      for (int i = gt; i < DEPTH * AH * 128 * 128; i += NGT) { const int jj = i & 127, ii = (i >> 7) & 127; wsm[i] = (jj <= ii) ? f2bf1(ws_[i]) : (unsigned short)0; } }
    for (int i = gt; i < DEPTH * NG * NP; i += NGT) {
        const int l = i / (NG * NP), gp = i % (NG * NP), g = gp / NP, p = gp % NP;
        unsigned char* base = F.ws + WS_S5P + (size_t)l * S5P_STRIDE;
        const double dt = exp((double)args.in[13][l * NG + g]);
        const double lr = (double)args.in[11][i], li = (double)args.in[12][i];
        const double mag = exp(lr * dt), ar = mag * cos(li * dt), ai = mag * sin(li * dt);
        const double nr = ar - 1.0, ni = ai, den = lr * lr + li * li;
        const double fr = (nr * lr + ni * li) / den, fi = (ni * lr - nr * li) / den;
        const double m32 = exp(32.0 * lr * dt), m128 = exp(128.0 * lr * dt);
        float* A = (float*)(base + S5P_A);
        A[0 * 1536 + gp] = (float)ar; A[1 * 1536 + gp] = (float)ai;
        A[2 * 1536 + gp] = (float)(m32 * cos(32.0 * li * dt)); A[3 * 1536 + gp] = (float)(m32 * sin(32.0 * li * dt));
        A[4 * 1536 + gp] = (float)(m128 * cos(128.0 * li * dt)); A[5 * 1536 + gp] = (float)(m128 * sin(128.0 * li * dt));
        { const double m1k = exp(1024.0 * lr * dt); A[6 * 1536 + gp] = (float)(m1k * cos(1024.0 * li * dt)); A[7 * 1536 + gp] = (float)(m1k * sin(1024.0 * li * dt)); }
        bf16* bm = (bf16*)(base + S5P_BMAT) + (size_t)g * 128 * 16;
        const float* bre = args.in[14] + (size_t)i * 16; const float* bim = args.in[15] + (size_t)i * 16;
        for (int c = 0; c < 16; ++c) { const double br = bre[c], bi = bim[c];
            bm[p * 16 + c] = f2bf1((float)(fr * br - fi * bi)); bm[(64 + p) * 16 + c] = f2bf1((float)(fr * bi + fi * br)); }
        bf16* cm = (bf16*)(base + S5P_CMAT) + (size_t)g * 16 * 128;
        const float* cre = args.in[16] + ((size_t)(l * NG + g) * 16) * NP; const float* cim = args.in[17] + ((size_t)(l * NG + g) * 16) * NP;
        for (int c = 0; c < 16; ++c) { cm[c * 128 + p] = f2bf1(cre[c * NP + p]); cm[c * 128 + 64 + p] = f2bf1(-cim[c * NP + p]); }
    }
    { f32x2* rope = (f32x2*)(F.ws + WS_ROPE);
      for (int i = gt; i < (PAST + STOK) * 8; i += NGT) { const int pos = i >> 3, k = i & 7; const double inv = pow(500000.0, -(double)k / 8.0), ang = (double)pos * inv;
          rope[i] = (f32x2){(float)cos(ang), (float)sin(ang)}; } }
    { bf16* XB = (bf16*)(F.ws + WS_XB); float* rss = (float*)(F.ws + WS_RSS);
      for (int row = gw; row < MR; row += NGW) {
          const float* xr = row < MP ? args.in[0] + (size_t)row * DM : args.in[1] + (size_t)(row - MP) * DM;
          const f32x4* x4 = (const f32x4*)xr + F.lane; float s = 0.f; f32x4 v[4];
#pragma unroll
          for (int j = 0; j < 4; ++j) { v[j] = x4[64 * j]; s += (v[j].x * v[j].x + v[j].y * v[j].y) + (v[j].z * v[j].z + v[j].w * v[j].w); }
          s = wave_sum(s);
          u32x2* o = (u32x2*)(XB + (size_t)row * DM) + F.lane;
#pragma unroll
          for (int j = 0; j < 4; ++j) o[64 * j] = (u32x2){cvtpk(v[j].x, v[j].y), cvtpk(v[j].z, v[j].w)};
          if (F.lane < 32) rss[(size_t)row * 32 + F.lane] = (F.lane == 0) ? s : 0.f;
      } }
}

DI int tok_of(int b, int r, int D, int i) { return b * SEQ + r + D * i; }

struct ApUnit { int br, b, h, D, r, J; };
DI ApUnit ap_decode(int unit) { ApUnit a; a.br = unit / 384; int rem = unit % 384; a.b = rem / 192; rem %= 192; a.h = rem / 32; const int blk = rem % 32;
    a.D = a.br == 0 ? 1 : (a.br == 1 ? 4 : 16); const int nper = (SEQ / a.D) / 256; a.r = blk / nper; a.J = blk % nper; return a; }
DI void ap_fetch(Frame& F, const ApUnit& a, u32x4 (&kr)[6], u32x4 (&vr)[6], bf16x8 (&qf)[4]) {
    const bf16* PROJ = (const bf16*)(F.ws + WS_PROJ); const int ibase = 256 * a.J - 128;
#pragma unroll
    for (int it = 0; it < 6; ++it) { const int id = F.tid + NTHR * it, kk = id >> 3, c = id & 7, i = ibase + kk;
        kr[it] = (u32x4){0u, 0u, 0u, 0u}; vr[it] = (u32x4){0u, 0u, 0u, 0u};
        if (i >= 0) { const bf16* rp = PROJ + (size_t)tok_of(a.b, a.r, a.D, i) * INW + a.h * HD + 8 * c; kr[it] = *(const u32x4*)(rp + O_K); vr[it] = *(const u32x4*)(rp + O_VV); } }
    const int qtok = tok_of(a.b, a.r, a.D, 256 * a.J + 32 * F.wave + (F.lane & 31));
#pragma unroll
    for (int s = 0; s < 4; ++s) qf[s] = *(const bf16x8*)(PROJ + (size_t)qtok * INW + O_Q + a.h * HD + 16 * s + 8 * (F.lane >> 5));
}
DI int ap_unit_of(int c, int i, int G, int count) {
    const int base = i * G, left = count - base;
    if (((G | left) & 7) != 0 || left >= 2 * G) { if (((G | (count % G)) & 7) != 0) { const int u = c + base; return u < count ? u : -1; } }
    if (left <= 0) return -1;
    const int n = left >= G ? G : left;
    return c < n ? base + (c & 7) * (n >> 3) + (c >> 3) : -1;
}
DI void attn_prompt_phase(Frame& F, int first, int count, int stride) {
    launder(F);
    int rnd = 0; int unit = ap_unit_of(first, 0, stride, count); if (unit < 0) return;
    LAS unsigned char* Ks = F.lds;
    LAS unsigned char* Vs = F.lds + 384 * 144;
    const int w = F.wave, l31 = F.lane & 31, hh = F.lane >> 5;
    u32x4 kr[6], vr[6]; bf16x8 qf[4];
    ApUnit a = ap_decode(unit); ap_fetch(F, a, kr, vr, qf);
    for (; unit >= 0; ) {
        const int nunit = ap_unit_of(first, ++rnd, stride, count);
#pragma unroll
        for (int it = 0; it < 6; ++it) { const int id = F.tid + NTHR * it, kk = id >> 3, c = id & 7; *(LAS u32x4*)(Ks + kk * 144 + c * 16) = kr[it]; *(LAS u32x4*)(Vs + kk * 144 + c * 16) = vr[it]; }
        const ApUnit cu = a; const int ibase = 256 * cu.J - 128;
        bf16x8 qc[4];
#pragma unroll
        for (int s = 0; s < 4; ++s) qc[s] = qf[s];
        __syncthreads();
        if (nunit >= 0) { a = ap_decode(nunit); ap_fetch(F, a, kr, vr, qf); }
        f32x16 S[5];
#pragma unroll
        for (int t = 0; t < 5; ++t) { S[t] = zero16(); bf16x8 kfr[4];
#pragma unroll
            for (int s = 0; s < 4; ++s) kfr[s] = *(const LAS bf16x8*)(Ks + (32 * w + 32 * t + l31) * 144 + (16 * s + 8 * hh) * 2);
            asm volatile("" : "+v"(kfr[0]), "+v"(kfr[1]), "+v"(kfr[2]), "+v"(kfr[3]));
#pragma unroll
            for (int s = 0; s < 4; ++s) S[t] = mfma32(kfr[s], qc[s], S[t]);
            __builtin_amdgcn_sched_barrier(0); }
        const float NEG = -3.0e38f;
        if (cu.J == 0) {
#pragma unroll
            for (int t = 0; t < 4; ++t)
#pragma unroll
                for (int rg = 0; rg < 16; ++rg) { if (32 * w + 32 * t + crow(rg, hh) < 128) S[t][rg] = NEG; }
        }
        float mx = NEG;
#pragma unroll
        for (int rg = 0; rg < 16; ++rg) { const int k0 = crow(rg, hh); S[0][rg] = (k0 >= l31) ? S[0][rg] : NEG; S[4][rg] = (k0 <= l31) ? S[4][rg] : NEG; }
#pragma unroll
        for (int t = 0; t < 5; ++t)
#pragma unroll
            for (int rg = 0; rg < 16; ++rg) mx = fmaxf(mx, S[t][rg]);
        mx = fmaxf(mx, __shfl_xor(mx, 32));
        const float c2 = 0.125f * 1.4426950409f, mc = mx * c2; float lsum = 0.f;
#pragma unroll
        for (int t = 0; t < 5; ++t)
#pragma unroll
            for (int rg = 0; rg < 16; ++rg) { const float pe = __builtin_amdgcn_exp2f(S[t][rg] * c2 - mc); S[t][rg] = pe; lsum += pe; }
        lsum += __shfl_xor(lsum, 32);
        f32x16 O[2]; O[0] = zero16(); O[1] = zero16();
        const int q4 = (F.lane & 15) >> 2, p4 = F.lane & 3, grp = (F.lane >> 4) & 1;
#pragma unroll
        for (int t = 0; t < 5; ++t)
#pragma unroll
            for (int s2 = 0; s2 < 2; ++s2) {
                u32x4 pw; pw.x = cvtpk(S[t][8 * s2 + 0], S[t][8 * s2 + 1]); pw.y = cvtpk(S[t][8 * s2 + 2], S[t][8 * s2 + 3]); pw.z = cvtpk(S[t][8 * s2 + 4], S[t][8 * s2 + 5]); pw.w = cvtpk(S[t][8 * s2 + 6], S[t][8 * s2 + 7]);
                const bf16x8 pf = __builtin_bit_cast(bf16x8, pw);
#pragma unroll
                for (int dt = 0; dt < 2; ++dt) {
                    LAS unsigned char* vp = Vs + (32 * w + 32 * t + 16 * s2 + 4 * hh + q4) * 144 + (32 * dt + 16 * grp) * 2 + 8 * p4;
                    const s16x4 lo = __builtin_bit_cast(s16x4, __builtin_amdgcn_ds_read_tr16_b64_v4i16((LAS s16x4*)vp));
                    const s16x4 hi4 = __builtin_bit_cast(s16x4, __builtin_amdgcn_ds_read_tr16_b64_v4i16((LAS s16x4*)(vp + 8 * 144)));
                    O[dt] = mfma32(__builtin_shufflevector(lo, hi4, 0, 1, 2, 3, 4, 5, 6, 7), pf, O[dt]);
                }
                __builtin_amdgcn_sched_barrier(0);
            }
        const float inv = 1.0f / lsum;
        const int qtok = tok_of(cu.b, cu.r, cu.D, 256 * cu.J + 32 * w + l31);
        bf16* OP = (bf16*)(F.ws + WS_OP) + ((size_t)cu.br * MP + qtok) * CWD + cu.h * HD;
#pragma unroll
        for (int dt = 0; dt < 2; ++dt)
#pragma unroll
            for (int g4 = 0; g4 < 4; ++g4) { u32x2 o; o.x = cvtpk(O[dt][4 * g4] * inv, O[dt][4 * g4 + 1] * inv); o.y = cvtpk(O[dt][4 * g4 + 2] * inv, O[dt][4 * g4 + 3] * inv);
                *(u32x2*)(OP + 32 * dt + 8 * g4 + 4 * hh) = o; }
        if (hh == 0) ((float*)(F.ws + WS_LSE))[((size_t)cu.br * MP + qtok) * CH + cu.h] = mx * 0.125f + __logf(lsum);
        __syncthreads();
        unit = nunit;
    }
}

DI void sgu_prompt_unit(const Args& args, Frame& F, int layer, int ch) {
    launder(F);
    const int R0 = (ch >> 6) * SEQ + (ch & 63) * 128;
    const bf16* PROJ = (const bf16*)(F.ws + WS_PROJ);
    LAS unsigned char* Vn = F.lds;
    const int w = F.wave, lane = F.lane, l31 = lane & 31, hh = lane >> 5;
    { u32x2 raw[16];
#pragma unroll
      for (int t = 0; t < 16; ++t) raw[t] = *(const u32x2*)(PROJ + (size_t)(R0 + 16 * w + t) * INW + O_V + 4 * lane);
#pragma unroll
      for (int t = 0; t < 16; ++t) {
          float v[4] = {__uint_as_float(raw[t].x << 16), __uint_as_float(raw[t].x & 0xffff0000u), __uint_as_float(raw[t].y << 16), __uint_as_float(raw[t].y & 0xffff0000u)};
          const float mean = wave_sum((v[0] + v[1]) + (v[2] + v[3])) * (1.0f / 256.0f);
          float q = 0.f;
#pragma unroll
          for (int e2 = 0; e2 < 4; ++e2) { v[e2] -= mean; q += v[e2] * v[e2]; }
          const float rstd = 1.0f / sqrtf(wave_sum(q) * (1.0f / 256.0f) + EPSN);
          *(LAS u32x2*)(Vn + (16 * w + t) * 528 + lane * 8) = (u32x2){cvtpk(v[0] * rstd, v[1] * rstd), cvtpk(v[2] * rstd, v[3] * rstd)}; } }
    const int hd = w >> 1, ih = w & 1;
    const bf16* Wm = (const bf16*)(F.ws + WS_WSM) + ((size_t)(layer * AH + hd) * 128) * 128;
    bf16x8 af[2][8];
#pragma unroll
    for (int s2 = 0; s2 < 8; ++s2)
#pragma unroll
        for (int mt = 0; mt < 2; ++mt) { const int sc_ = s2 < 4 * (ih + 1) ? s2 : 0; af[mt][s2] = *(const bf16x8*)(Wm + (size_t)(64 * ih + 32 * mt + l31) * 128 + 16 * sc_ + 8 * hh); }
    __syncthreads();
    f32x16 acc[2][2]; acc[0][0] = zero16(); acc[0][1] = zero16(); acc[1][0] = zero16(); acc[1][1] = zero16();
    const int q4 = (lane & 15) >> 2, p4 = lane & 3, grp = (lane >> 4) & 1;
#pragma unroll
    for (int s2 = 0; s2 < 8; ++s2) if (s2 < 4 * (ih + 1)) {
        bf16x8 bfr[2];
#pragma unroll
        for (int nt = 0; nt < 2; ++nt) {
            LAS unsigned char* vp = Vn + (16 * s2 + 8 * hh + q4) * 528 + (64 * hd + 32 * nt + 16 * grp) * 2 + 8 * p4;
            const s16x4 lo = __builtin_bit_cast(s16x4, __builtin_amdgcn_ds_read_tr16_b64_v4i16((LAS s16x4*)vp));
            const s16x4 hi4 = __builtin_bit_cast(s16x4, __builtin_amdgcn_ds_read_tr16_b64_v4i16((LAS s16x4*)(vp + 4 * 528)));
            bfr[nt] = __builtin_shufflevector(lo, hi4, 0, 1, 2, 3, 4, 5, 6, 7); }
#pragma unroll
        for (int mt = 0; mt < 2; ++mt)
#pragma unroll
            for (int nt = 0; nt < 2; ++nt) acc[mt][nt] = mfma32(af[mt][s2], bfr[nt], acc[mt][nt]);
    }
    const float* bs = args.in[10] + (size_t)(layer * AH + hd) * 128;
    f32x4 bq[2][4];
#pragma unroll
    for (int mt = 0; mt < 2; ++mt)
#pragma unroll
        for (int q = 0; q < 4; ++q) bq[mt][q] = *(const f32x4*)(bs + 64 * ih + 32 * mt + 8 * q + 4 * hh);
    __syncthreads();
    asm volatile("" : "+v"(bq[0][0]), "+v"(bq[0][1]), "+v"(bq[0][2]), "+v"(bq[0][3]), "+v"(bq[1][0]), "+v"(bq[1][1]), "+v"(bq[1][2]), "+v"(bq[1][3]));
#pragma unroll
    for (int mt = 0; mt < 2; ++mt)
#pragma unroll
        for (int rg = 0; rg < 16; ++rg) { const int i = 64 * ih + 32 * mt + crow(rg, hh); const float bb = bq[mt][rg >> 2][rg & 3];
#pragma unroll
            for (int nt = 0; nt < 2; ++nt) *(LAS unsigned short*)(Vn + i * 528 + (64 * hd + 32 * nt + l31) * 2) = f2bf1(acc[mt][nt][rg] + bb); }
    bf16* MIX = (bf16*)(F.ws + WS_MIX);
    int tid2 = F.tid; asm volatile("" : "+v"(tid2));
    u32x4 uu8[8];
#pragma unroll
    for (int it = 0; it < 8; ++it) { const int id = tid2 + NTHR * it, row = id >> 5, c = id & 31; uu8[it] = *(const u32x4*)(PROJ + (size_t)(R0 + row) * INW + O_U + 8 * c); }
    __syncthreads();
    asm volatile("" : "+v"(uu8[0]), "+v"(uu8[1]), "+v"(uu8[2]), "+v"(uu8[3]), "+v"(uu8[4]), "+v"(uu8[5]), "+v"(uu8[6]), "+v"(uu8[7]));
#pragma unroll
    for (int it = 0; it < 8; ++it) { const int id = tid2 + NTHR * it, row = id >> 5, c = id & 31;
        const u32x4 uu = uu8[it], mm = *(const LAS u32x4*)(Vn + row * 528 + c * 16);
        u32x4 o;
#pragma unroll
        for (int e2 = 0; e2 < 4; ++e2) o[e2] = cvtpk(__uint_as_float(uu[e2] << 16) * __uint_as_float(mm[e2] << 16), __uint_as_float(uu[e2] & 0xffff0000u) * __uint_as_float(mm[e2] & 0xffff0000u));
        *(u32x4*)(MIX + (size_t)(R0 + row) * DM + 8 * c) = o; }
    __syncthreads();
}

struct S5W { bf16x8 bfr[4]; float ar0, ai0, ar1, ai1; };
DI void s5_load_group(Frame& F, int layer, int g, S5W& W) {
    const unsigned char* base = F.ws + WS_S5P + (size_t)layer * S5P_STRIDE; const int l31 = F.lane & 31, hh = F.lane >> 5;
    const bf16* bm = (const bf16*)(base + S5P_BMAT) + (size_t)g * 128 * 16;
#pragma unroll
    for (int nt = 0; nt < 4; ++nt) W.bfr[nt] = *(const bf16x8*)(bm + (32 * nt + l31) * 16 + 8 * hh);
    const float* A = (const float*)(base + S5P_A);
    W.ar0 = A[g * NP + l31]; W.ai0 = A[1536 + g * NP + l31]; W.ar1 = A[g * NP + 32 + l31]; W.ai1 = A[1536 + g * NP + 32 + l31];
}
DI bf16x8 s5_afrag(Frame& F, int g, int tbase) {
    const bf16* PROJ = (const bf16*)(F.ws + WS_PROJ); const int l31 = F.lane & 31, hh = F.lane >> 5;
    const int tt = (l31 & 3) + 4 * (l31 >> 3), bb = (l31 >> 2) & 1;
    return *(const bf16x8*)(PROJ + (size_t)(bb * SEQ + tbase + tt) * INW + O_S5 + 16 * g + 8 * hh);
}
DI void s5_tile(const S5W& W, const bf16x8 af, f32x16 (&X)[4], float& hr0, float& hi0, float& hr1, float& hi1) {
#pragma unroll
    for (int nt = 0; nt < 4; ++nt) X[nt] = mfma32(af, W.bfr[nt], zero16());
#pragma unroll
    for (int rg = 0; rg < 16; ++rg) {
        const float nr0 = W.ar0 * hr0 - W.ai0 * hi0 + X[0][rg], ni0 = W.ar0 * hi0 + W.ai0 * hr0 + X[2][rg];
        const float nr1 = W.ar1 * hr1 - W.ai1 * hi1 + X[1][rg], ni1 = W.ar1 * hi1 + W.ai1 * hr1 + X[3][rg];
        hr0 = nr0; hi0 = ni0; hr1 = nr1; hi1 = ni1; X[0][rg] = nr0; X[2][rg] = ni0; X[1][rg] = nr1; X[3][rg] = ni1;
    }
}
DI void cmul_acc(float& hr, float& hi, float ar, float ai, float xr, float xi) { const float nr = ar * hr - ai * hi + xr, ni = ar * hi + ai * hr + xi; hr = nr; hi = ni; }
DI void s5_pass1_unit(Frame& F, int layer, int S, int g) {
    launder(F);
    S5W W; s5_load_group(F, layer, g, W);
    const int l31 = F.lane & 31, hh = F.lane >> 5, w = F.wave, C = 8 * S + w;
    float hr0 = 0.f, hi0 = 0.f, hr1 = 0.f, hi1 = 0.f;
    f32x2* L = (f32x2*)(F.ws + WS_S5L);
    bf16x8 afs[8];
#pragma unroll
    for (int k = 0; k < 8; ++k) afs[k] = s5_afrag(F, g, 128 * C + 16 * k);
    asm volatile("" : "+v"(afs[0]), "+v"(afs[1]), "+v"(afs[2]), "+v"(afs[3]), "+v"(afs[4]), "+v"(afs[5]), "+v"(afs[6]), "+v"(afs[7]));
#pragma unroll
    for (int k = 0; k < 8; ++k) {
        f32x16 X[4]; s5_tile(W, afs[k], X, hr0, hi0, hr1, hi1);
        if (k & 1) { const size_t idx = ((((size_t)C * 4 + (k >> 1)) * 2 + hh) * NG + g) * NP + l31; L[idx] = (f32x2){hr0, hi0}; L[idx + 32] = (f32x2){hr1, hi1}; }
    }
    LAS f32x4* es = (LAS f32x4*)F.lds;
    es[w * 64 + F.lane] = (f32x4){hr0, hi0, hr1, hi1};
    __syncthreads();
    const float* A = (const float*)(F.ws + WS_S5P + (size_t)layer * S5P_STRIDE + S5P_A);
    const float br0 = A[4 * 1536 + g * NP + l31], bi0 = A[5 * 1536 + g * NP + l31], br1 = A[4 * 1536 + g * NP + 32 + l31], bi1 = A[5 * 1536 + g * NP + 32 + l31];
    float pr0 = 0.f, pi0 = 0.f, pr1 = 0.f, pi1 = 0.f;
    for (int q = 0; q < w; ++q) { const f32x4 e = es[q * 64 + F.lane]; cmul_acc(pr0, pi0, br0, bi0, e.x, e.y); cmul_acc(pr1, pi1, br1, bi1, e.z, e.w); }
    { f32x2* PW = (f32x2*)(F.ws + WS_S5PW); const size_t idx = (((size_t)C * 2 + hh) * NG + g) * NP + l31; PW[idx] = (f32x2){pr0, pi0}; PW[idx + 32] = (f32x2){pr1, pi1}; }
    if (w == 7) { cmul_acc(pr0, pi0, br0, bi0, hr0, hi0); cmul_acc(pr1, pi1, br1, bi1, hr1, hi1);
        f32x2* SE = (f32x2*)(F.ws + WS_S5SE); const size_t idx = (((size_t)S * 2 + hh) * NG + g) * NP + l31; SE[idx] = (f32x2){pr0, pi0}; SE[idx + 32] = (f32x2){pr1, pi1}; }
    __syncthreads();
}

DI void sgu_sample_unit(const Args& args, Frame& F, int layer, int sb) {
    launder(F);
    const bf16* PROJ = (const bf16*)(F.ws + WS_PROJ); const int R0 = MP + sb * STOK;
    LAS float* vn = (LAS float*)F.lds;
    { const int t = F.wave; const bf16* vr = PROJ + (size_t)(R0 + t) * INW + O_V + 4 * F.lane;
      const u32x2 rw = *(const u32x2*)vr; float v[4] = {__uint_as_float(rw.x << 16), __uint_as_float(rw.x & 0xffff0000u), __uint_as_float(rw.y << 16), __uint_as_float(rw.y & 0xffff0000u)};
      const float mean = wave_sum((v[0] + v[1]) + (v[2] + v[3])) * (1.0f / 256.0f);
      float q = 0.f;
#pragma unroll
      for (int e = 0; e < 4; ++e) { v[e] -= mean; q += v[e] * v[e]; }
      const float rstd = 1.0f / sqrtf(wave_sum(q) * (1.0f / 256.0f) + EPSN);
      float* sg = F.out + OUT_SGV + ((size_t)(layer * SBATCH + sb) * STOK + t) * AW + 4 * F.lane;
#pragma unroll
      for (int e = 0; e < 4; ++e) { v[e] *= rstd; vn[t * 256 + 4 * F.lane + e] = v[e]; }
      *(f32x4*)sg = (f32x4){v[0], v[1], v[2], v[3]}; }
    __syncthreads();
    bf16* MIX = (bf16*)(F.ws + WS_MIX);
#pragma unroll
    for (int q = 0; q < 4; ++q) { const int o = F.tid + NTHR * q, i = o >> 8, col = o & 255, hd = col >> 6;
        const float* wr = args.in[9] + ((size_t)(layer * AH + hd) * 128 + i) * 128;
        const f32x4 w0 = *(const f32x4*)wr, w1 = *(const f32x4*)(wr + 4);
        float a = args.in[10][(size_t)(layer * AH + hd) * 128 + i];
        const float wv[8] = {w0.x, w0.y, w0.z, w0.w, w1.x, w1.y, w1.z, w1.w};
#pragma unroll
        for (int j = 0; j < 8; ++j) a += (j <= i ? wv[j] : 0.f) * vn[j * 256 + col];
        const float uu = bf2f(PROJ[(size_t)(R0 + i) * INW + O_U + col]);
        MIX[(size_t)(R0 + i) * DM + col] = f2bf1(uu * a); }
    __syncthreads();
}

DI void s5_sample_unit(const Args& args, Frame& F, int layer, int unit) {
    launder(F);
    const int sb = unit / 3, part = unit % 3, g = 8 * part + F.wave, p = F.lane;
    const bf16* PROJ = (const bf16*)(F.ws + WS_PROJ); const int R0 = MP + sb * STOK;
    const unsigned char* base = F.ws + WS_S5P + (size_t)layer * S5P_STRIDE;
    LAS float* us = (LAS float*)F.lds;
    LAS float* hw = us + 8 * 384 + F.wave * (8 * 64 * 2);
    LAS float* cms = us + 8 * 384 + 8 * (8 * 64 * 2) + F.wave * (16 * 128);
    { const bf16* cm = (const bf16*)(base + S5P_CMAT) + (size_t)g * 16 * 128;
      unsigned uv[6]; u32x4 rwq[4];
#pragma unroll
      for (int q = 0; q < 6; ++q) { const int i = F.tid + NTHR * q, t = i / 384, c = i % 384; uv[q] = PROJ[(size_t)(R0 + t) * INW + O_S5 + c]; }
#pragma unroll
      for (int q = 0; q < 4; ++q) rwq[q] = *(const u32x4*)(cm + 8 * (p + 64 * q));
      asm volatile("" : "+v"(uv[0]), "+v"(uv[1]), "+v"(uv[2]), "+v"(uv[3]), "+v"(uv[4]), "+v"(uv[5]), "+v"(rwq[0]), "+v"(rwq[1]), "+v"(rwq[2]), "+v"(rwq[3]));
#pragma unroll
      for (int q = 0; q < 6; ++q) us[F.tid + NTHR * q] = __uint_as_float(uv[q] << 16);
#pragma unroll
      for (int q = 0; q < 4; ++q) { const int ch = p + 64 * q; const u32x4 rw = rwq[q];
#pragma unroll
          for (int e2 = 0; e2 < 4; ++e2) { cms[8 * ch + 2 * e2] = __uint_as_float(rw[e2] << 16); cms[8 * ch + 2 * e2 + 1] = __uint_as_float(rw[e2] & 0xffff0000u); } } }
    __syncthreads();
    const bf16* bm = (const bf16*)(base + S5P_BMAT) + (size_t)g * 128 * 16;
    const float* A = (const float*)(base + S5P_A);
    const float ar = A[g * NP + p], ai = A[1536 + g * NP + p];
    float bre[16], bim[16];
    { const u32x4* b0 = (const u32x4*)(bm + p * 16); const u32x4* b1 = (const u32x4*)(bm + (64 + p) * 16);
#pragma unroll
      for (int q = 0; q < 2; ++q) { const u32x4 x = b0[q], y = b1[q];
#pragma unroll
          for (int e2 = 0; e2 < 4; ++e2) { bre[8 * q + 2 * e2] = __uint_as_float(x[e2] << 16); bre[8 * q + 2 * e2 + 1] = __uint_as_float(x[e2] & 0xffff0000u);
                                          bim[8 * q + 2 * e2] = __uint_as_float(y[e2] << 16); bim[8 * q + 2 * e2 + 1] = __uint_as_float(y[e2] & 0xffff0000u); } } }
    const size_t sidx = ((size_t)(layer * SBATCH + sb) * NG + g) * NP + p;
    float hr = args.in[4][sidx], hi = args.in[5][sidx];
#pragma unroll
    for (int t = 0; t < 8; ++t) {
        float xr = 0.f, xi = 0.f;
#pragma unroll
        for (int c = 0; c < 16; ++c) { const float uu = us[t * 384 + 16 * g + c]; xr += bre[c] * uu; xi += bim[c] * uu; }
        const float nr = ar * hr - ai * hi + xr, ni = ar * hi + ai * hr + xi; hr = nr; hi = ni;
        hw[(t * 64 + p) * 2] = hr; hw[(t * 64 + p) * 2 + 1] = hi;
    }
    F.out[OUT_SRS + sidx] = hr; F.out[OUT_SIS + sidx] = hi;
    LDS_WAIT(); asm volatile("" ::: "memory");
    { const int t = F.lane >> 3, c0 = F.lane & 7;
      float y0 = 0.f, y1 = 0.f;
#pragma unroll 8
      for (int pp = 0; pp < 64; ++pp) { const float hre = hw[(t * 64 + pp) * 2], him = hw[(t * 64 + pp) * 2 + 1];
          y0 += cms[c0 * 128 + pp] * hre + cms[c0 * 128 + 64 + pp] * him;
          y1 += cms[(c0 + 8) * 128 + pp] * hre + cms[(c0 + 8) * 128 + 64 + pp] * him; }
      const float* dsk = args.in[18] + (size_t)layer * BW + 16 * g;
      y0 += dsk[c0] * us[t * 384 + 16 * g + c0]; y1 += dsk[c0 + 8] * us[t * 384 + 16 * g + c0 + 8];
      bf16* gsm = (bf16*)(F.ws + WS_GSMP) + (size_t)(sb * STOK + t) * BW + 16 * g;
      gsm[c0] = f2bf1(gelu_t(y0)); gsm[c0 + 8] = f2bf1(gelu_t(y1)); }
    __syncthreads();
}

DI float row16_sum(float x) {
    x += __builtin_bit_cast(float, __builtin_amdgcn_update_dpp(0, __builtin_bit_cast(int, x), 0x128, 0xf, 0xf, false));
    x += __builtin_bit_cast(float, __builtin_amdgcn_update_dpp(0, __builtin_bit_cast(int, x), 0x124, 0xf, 0xf, false));
    x += __builtin_bit_cast(float, __builtin_amdgcn_update_dpp(0, __builtin_bit_cast(int, x), 0x122, 0xf, 0xf, false));
    x += __builtin_bit_cast(float, __builtin_amdgcn_update_dpp(0, __builtin_bit_cast(int, x), 0x121, 0xf, 0xf, false));
    return x;
}
DI void attn_sample_unit(const Args& args, Frame& F, int layer, int unit) {
    launder(F);
    const int br = unit / 192, rem = unit % 192, sb = rem / CH, h = rem % CH, i = F.wave, lane = F.lane;
    const int dil = br == 0 ? 1 : (br == 1 ? 4 : 16);
    const int rg = lane >> 4, dq = lane & 15;
    const bf16* PROJ = (const bf16*)(F.ws + WS_PROJ); const int R0 = MP + sb * STOK;
    float q4[4];
#pragma unroll
    for (int e = 0; e < 4; ++e) q4[e] = 0.125f * bf2f(PROJ[(size_t)(R0 + i) * INW + O_Q + h * HD + rope_phys(4 * dq + e)]);
    const float* ck = args.in[2] + ((size_t)(layer * SBATCH + sb) * CWIN) * CWD + h * HD + 4 * dq;
    const float* cv = args.in[3] + ((size_t)(layer * SBATCH + sb) * CWIN) * CWD + h * HD + 4 * dq;
    const float* nk = F.out + OUT_KS + ((size_t)(layer * MS + sb * STOK) * CH + h) * HD + 4 * dq;
    const float* nv = F.out + OUT_VS + ((size_t)(layer * MS + sb * STOK) * CH + h) * HD + 4 * dq;
    float sc[33];
#define AS_KROW(jb) ({ const int j_ = 4 * (jb) + rg, jc_ = j_ > 128 ? 128 : j_, kp_ = PAST + i - dil * jc_; (kp_ < PAST) ? ck + (size_t)(kp_ - (PAST - CWIN)) * CWD : nk + (size_t)(kp_ - PAST) * CWD; })
#define AS_VROW(jb) ({ const int j_ = 4 * (jb) + rg, jc_ = j_ > 128 ? 128 : j_, kp_ = PAST + i - dil * jc_; (kp_ < PAST) ? cv + (size_t)(kp_ - (PAST - CWIN)) * CWD : nv + (size_t)(kp_ - PAST) * CWD; })
    { f32x4 ka[17];
#pragma unroll
      for (int jb = 0; jb < 17; ++jb) ka[jb] = *(const f32x4*)AS_KROW(jb);
      f32x4 kb[16];
#pragma unroll
      for (int jb = 0; jb < 16; ++jb) kb[jb] = *(const f32x4*)AS_KROW(17 + jb);
#pragma unroll
      for (int jb = 0; jb < 17; ++jb) sc[jb] = row16_sum(ka[jb].x * q4[0] + ka[jb].y * q4[1] + ka[jb].z * q4[2] + ka[jb].w * q4[3]);
#pragma unroll
      for (int jb = 0; jb < 16; ++jb) sc[17 + jb] = row16_sum(kb[jb].x * q4[0] + kb[jb].y * q4[1] + kb[jb].z * q4[2] + kb[jb].w * q4[3]); }
    if (rg != 0) sc[32] = -3.0e38f;
    f32x4 va[17];
#pragma unroll
    for (int jb = 0; jb < 17; ++jb) va[jb] = *(const f32x4*)AS_VROW(jb);
    float mx = sc[0];
#pragma unroll
    for (int jb = 1; jb < 33; ++jb) mx = fmaxf(mx, sc[jb]);
    mx = fmaxf(mx, __shfl_xor(mx, 16)); mx = fmaxf(mx, __shfl_xor(mx, 32));
    float lsum = 0.f;
#pragma unroll
    for (int jb = 0; jb < 33; ++jb) { sc[jb] = __expf(sc[jb] - mx); lsum += sc[jb]; }
    lsum += __shfl_xor(lsum, 16); lsum += __shfl_xor(lsum, 32);
    f32x4 o = (f32x4){0.f, 0.f, 0.f, 0.f};
    f32x4 vb[16];
#pragma unroll
    for (int jb = 0; jb < 16; ++jb) vb[jb] = *(const f32x4*)AS_VROW(17 + jb);
#pragma unroll
    for (int jb = 0; jb < 17; ++jb) { o.x += sc[jb] * va[jb].x; o.y += sc[jb] * va[jb].y; o.z += sc[jb] * va[jb].z; o.w += sc[jb] * va[jb].w; }
#pragma unroll
    for (int jb = 0; jb < 16; ++jb) { o.x += sc[17 + jb] * vb[jb].x; o.y += sc[17 + jb] * vb[jb].y; o.z += sc[17 + jb] * vb[jb].z; o.w += sc[17 + jb] * vb[jb].w; }
#undef AS_KROW
#undef AS_VROW
#pragma unroll
    for (int e = 0; e < 4; ++e) { o[e] += __shfl_xor(o[e], 16); o[e] += __shfl_xor(o[e], 32); }
    const float inv = 1.0f / lsum;
    const int row = sb * STOK + i;
    if (rg == 0) *(f32x4*)((float*)(F.ws + WS_OPS) + ((size_t)br * MS + row) * CWD + h * HD + 4 * dq) = (f32x4){o.x * inv, o.y * inv, o.z * inv, o.w * inv};
    if (lane == 0) ((float*)(F.ws + WS_LSES))[((size_t)br * MS + row) * CH + h] = mx + __logf(lsum);
}

DI void attn_merge(Frame& F) {
    launder(F);
    const bf16* OP = (const bf16*)(F.ws + WS_OP); const float* LSE = (const float*)(F.ws + WS_LSE); bf16* MIX = (bf16*)(F.ws + WS_MIX);
    const int gt = F.bid * NTHR + F.tid, NGT = F.G * NTHR;
    constexpr int NT = MP * CH * 8;
    for (int i0 = gt; i0 < NT; i0 += 2 * NGT) {
        float lw[2][3]; u32x4 pa[2][3]; int dst[2]; bool on[2];
#pragma unroll
        for (int k = 0; k < 2; ++k) { const int i = i0 + k * NGT; on[k] = i < NT; const int ic = on[k] ? i : i0; const int c = ic & 7, th = ic >> 3, h = th % CH, tok = th / CH;
            dst[k] = tok * DM + AW + BW + h * HD + 8 * c;
#pragma unroll
            for (int b = 0; b < 3; ++b) { lw[k][b] = LSE[((size_t)b * MP + tok) * CH + h]; pa[k][b] = *(const u32x4*)(OP + ((size_t)b * MP + tok) * CWD + h * HD + 8 * c); } }
#pragma unroll
        for (int k = 0; k < 2; ++k) if (on[k]) {
            const float ml = fmaxf(fmaxf(lw[k][0], lw[k][1]), lw[k][2]); float w0 = __expf(lw[k][0] - ml), w1 = __expf(lw[k][1] - ml), w2 = __expf(lw[k][2] - ml); const float iw = 1.0f / (w0 + w1 + w2); w0 *= iw; w1 *= iw; w2 *= iw;
            u32x4 o;
#pragma unroll
            for (int e2 = 0; e2 < 4; ++e2) { const float lo = w0 * __uint_as_float(pa[k][0][e2] << 16) + w1 * __uint_as_float(pa[k][1][e2] << 16) + w2 * __uint_as_float(pa[k][2][e2] << 16);
                const float hi2 = w0 * __uint_as_float(pa[k][0][e2] & 0xffff0000u) + w1 * __uint_as_float(pa[k][1][e2] & 0xffff0000u) + w2 * __uint_as_float(pa[k][2][e2] & 0xffff0000u); o[e2] = cvtpk(lo, hi2); }
            *(u32x4*)(MIX + (size_t)dst[k]) = o; }
    }
}

typedef float f32x4v __attribute__((ext_vector_type(4)));
DI void glu_tile(const Args& args, Frame& F, int layer, LAS unsigned char* Gs, int t0) {
    const int l15 = F.lane & 15, q4 = F.lane >> 4, w = F.wave;
    __syncthreads();
    const bf16* wg = (const bf16*)(F.ws + WS_WGLU + (size_t)layer * WGLU_STRIDE) + (size_t)(48 * w + l15) * BW + 8 * q4;
    f32x4v acc[4][3];
#pragma unroll
    for (int mt = 0; mt < 4; ++mt)
#pragma unroll
        for (int nt = 0; nt < 3; ++nt) acc[mt][nt] = (f32x4v){0.f, 0.f, 0.f, 0.f};
#pragma unroll 3
    for (int s = 0; s < 12; ++s) {
        bf16x8 a[4], b[3];
#pragma unroll
        for (int nt = 0; nt < 3; ++nt) b[nt] = *(const bf16x8*)(wg + (size_t)(16 * nt) * BW + 32 * s);
#pragma unroll
        for (int mt = 0; mt < 4; ++mt) a[mt] = *(const LAS bf16x8*)(Gs + (16 * mt + l15) * 784 + (32 * s + 8 * q4) * 2);
#pragma unroll
        for (int mt = 0; mt < 4; ++mt)
#pragma unroll
            for (int nt = 0; nt < 3; ++nt) acc[mt][nt] = __builtin_amdgcn_mfma_f32_16x16x32_bf16(a[mt], b[nt], acc[mt][nt], 0, 0, 0);
    }
    const float* bg = args.in[20] + (size_t)layer * BW;
    float bb3[3];
#pragma unroll
    for (int nt = 0; nt < 3; ++nt) bb3[nt] = bg[48 * w + 16 * nt + l15];
    __syncthreads();
    asm volatile("" : "+v"(bb3[0]), "+v"(bb3[1]), "+v"(bb3[2]));
#pragma unroll
    for (int nt = 0; nt < 3; ++nt) { const int n = 48 * w + 16 * nt + l15; const float bb = bb3[nt]; unsigned short gr[16];
#pragma unroll
        for (int mt = 0; mt < 4; ++mt)
#pragma unroll
            for (int r = 0; r < 4; ++r) gr[4 * mt + r] = *(const LAS unsigned short*)(Gs + (16 * mt + 4 * q4 + r) * 784 + n * 2);
#pragma unroll
        for (int mt = 0; mt < 4; ++mt)
#pragma unroll
            for (int r = 0; r < 4; ++r) *(LAS unsigned short*)(Gs + (16 * mt + 4 * q4 + r) * 784 + n * 2) = f2bf1(bf2f(gr[4 * mt + r]) * sigmoid_f(acc[mt][nt][r] + bb)); }
    __syncthreads();
    bf16* MIX = (bf16*)(F.ws + WS_MIX);
    int tid2 = F.tid; asm volatile("" : "+v"(tid2));
#pragma unroll
    for (int it = 0; it < 6; ++it) { const int id = tid2 + NTHR * it, r = id / 48, c = id % 48, tok = (r >> 5) * SEQ + t0 + (r & 31);
        *(u32x4*)(MIX + (size_t)tok * DM + AW + 8 * c) = *(const LAS u32x4*)(Gs + r * 784 + c * 16); }
    __syncthreads();
}

DI void attn_sample_merge(Frame& F) {
    launder(F);
    const float* OPS = (const float*)(F.ws + WS_OPS); const float* LS = (const float*)(F.ws + WS_LSES); bf16* MIX = (bf16*)(F.ws + WS_MIX);
    const int gt = F.bid * NTHR + F.tid, NGT = F.G * NTHR;
    for (int i = gt; i < MS * CH * 16; i += NGT) { const int dq = i & 15, rh = i >> 4, h = rh % CH, row = rh / CH;
        const float l0 = LS[(size_t)row * CH + h], l1 = LS[((size_t)MS + row) * CH + h], l2 = LS[((size_t)2 * MS + row) * CH + h];
        const float ml = fmaxf(fmaxf(l0, l1), l2); float w0 = __expf(l0 - ml), w1 = __expf(l1 - ml), w2 = __expf(l2 - ml); const float iw = 1.0f / (w0 + w1 + w2); w0 *= iw; w1 *= iw; w2 *= iw;
        const f32x4 a = *(const f32x4*)(OPS + (size_t)row * CWD + h * HD + 4 * dq), b = *(const f32x4*)(OPS + ((size_t)MS + row) * CWD + h * HD + 4 * dq), d = *(const f32x4*)(OPS + ((size_t)2 * MS + row) * CWD + h * HD + 4 * dq);
        u32x2 o; o.x = cvtpk(w0 * a.x + w1 * b.x + w2 * d.x, w0 * a.y + w1 * b.y + w2 * d.y); o.y = cvtpk(w0 * a.z + w1 * b.z + w2 * d.z, w0 * a.w + w1 * b.w + w2 * d.w);
        *(u32x2*)(MIX + (size_t)(MP + row) * DM + AW + BW + h * HD + 4 * dq) = o; }
}


struct S5G { S5W W; bf16x8 cf[8]; float dsk; };
DI void s5_load_group2(const Args& args, Frame& F, int layer, int g, S5G& G) {
    s5_load_group(F, layer, g, G.W);
    const unsigned char* base = F.ws + WS_S5P + (size_t)layer * S5P_STRIDE; const int l31 = F.lane & 31, hh = F.lane >> 5;
    const bf16* cm = (const bf16*)(base + S5P_CMAT) + (size_t)g * 16 * 128;
    const int lc = l31 & 15;
#pragma unroll
    for (int s = 0; s < 8; ++s) { u32x4 z = *(const u32x4*)(cm + lc * 128 + 16 * s + 8 * hh); if (l31 >= 16) z = (u32x4){0u, 0u, 0u, 0u}; G.cf[s] = __builtin_bit_cast(bf16x8, z); }
    G.dsk = args.in[18][(size_t)layer * BW + 16 * g + lc];
}
DI void s5_carry(Frame& F, int layer, int g, int C, int j, float& hr0, float& hi0, float& hr1, float& hi1) {
    const int l31 = F.lane & 31, hh = F.lane >> 5;
    const float* A = (const float*)(F.ws + WS_S5P + (size_t)layer * S5P_STRIDE + S5P_A);
    const f32x2* L = (const f32x2*)(F.ws + WS_S5L);
    hr0 = 0.f; hi0 = 0.f; hr1 = 0.f; hi1 = 0.f;
    const int Ssup = C >> 3, wch = C & 7;
    const float kr0 = A[6 * 1536 + g * NP + l31], ki0 = A[7 * 1536 + g * NP + l31], kr1 = A[6 * 1536 + g * NP + 32 + l31], ki1 = A[7 * 1536 + g * NP + 32 + l31];
    const f32x2* SE = (const f32x2*)(F.ws + WS_S5SE); f32x2 e0[7], e1[7];
#pragma unroll
    for (int q = 0; q < 7; ++q) { const int sq = q < Ssup ? q : 0; const size_t idx = (((size_t)sq * 2 + hh) * NG + g) * NP + l31; e0[q] = SE[idx]; e1[q] = SE[idx + 32]; }
    const f32x2* PW = (const f32x2*)(F.ws + WS_S5PW); const size_t pidx = (((size_t)C * 2 + hh) * NG + g) * NP + l31; const f32x2 pw0 = PW[pidx], pw1 = PW[pidx + 32];
    const int jm = j > 0 ? j - 1 : 0; const size_t lidx = ((((size_t)C * 4 + jm) * 2 + hh) * NG + g) * NP + l31; const f32x2 l0 = L[lidx], l1 = L[lidx + 32];
    const float br0 = A[4 * 1536 + g * NP + l31], bi0 = A[5 * 1536 + g * NP + l31], br1 = A[4 * 1536 + g * NP + 32 + l31], bi1 = A[5 * 1536 + g * NP + 32 + l31];
    const float cr0 = A[2 * 1536 + g * NP + l31], ci0 = A[3 * 1536 + g * NP + l31], cr1 = A[2 * 1536 + g * NP + 32 + l31], ci1 = A[3 * 1536 + g * NP + 32 + l31];
#pragma unroll
    for (int q = 0; q < 7; ++q) if (q < Ssup) { cmul_acc(hr0, hi0, kr0, ki0, e0[q].x, e0[q].y); cmul_acc(hr1, hi1, kr1, ki1, e1[q].x, e1[q].y); }
    for (int q = 0; q < wch; ++q) { cmul_acc(hr0, hi0, br0, bi0, 0.f, 0.f); cmul_acc(hr1, hi1, br1, bi1, 0.f, 0.f); }
    hr0 += pw0.x; hi0 += pw0.y; hr1 += pw1.x; hi1 += pw1.y;
    if (j > 0) { for (int q = 0; q < j; ++q) { cmul_acc(hr0, hi0, cr0, ci0, 0.f, 0.f); cmul_acc(hr1, hi1, cr1, ci1, 0.f, 0.f); }
        hr0 += l0.x; hi0 += l0.y; hr1 += l1.x; hi1 += l1.y; }
}
DI void s5_pass2_unit(const Args& args, Frame& F, int layer, int sc) {
    launder(F);
    const int C = sc >> 2, j = sc & 3, t0 = 32 * sc;
    const bf16* PROJ = (const bf16*)(F.ws + WS_PROJ);
    const int l31 = F.lane & 31, hh = F.lane >> 5, w = F.wave;
    LAS unsigned char* img = F.lds + w * 8192;
    LAS unsigned char* Gs = F.lds + 65536;
    u32x4 ut[6];
#pragma unroll
    for (int it = 0; it < 6; ++it) { const int id = F.tid + NTHR * it, r = id / 48, c = id % 48;
        ut[it] = *(const u32x4*)(PROJ + (size_t)((r >> 5) * SEQ + t0 + (r & 31)) * INW + O_S5 + 8 * c); }
    asm volatile("" : "+v"(ut[0]), "+v"(ut[1]), "+v"(ut[2]), "+v"(ut[3]), "+v"(ut[4]), "+v"(ut[5]));
#pragma unroll
    for (int it = 0; it < 6; ++it) { const int id = F.tid + NTHR * it, r = id / 48, c = id % 48; *(LAS u32x4*)(Gs + r * 784 + c * 16) = ut[it]; }
    float cr[3][4];
#pragma unroll
    for (int gi = 0; gi < 3; ++gi) s5_carry(F, layer, 3 * w + gi, C, j, cr[gi][0], cr[gi][1], cr[gi][2], cr[gi][3]);
    S5G Gn; s5_load_group2(args, F, layer, 3 * w, Gn);
    __syncthreads();
    const int tt = (l31 & 3) + 4 * (l31 >> 3), bb = (l31 >> 2) & 1;
#pragma unroll
    for (int gi = 0; gi < 3; ++gi) {
        const int g = 3 * w + gi;
        const S5G G = Gn;
        if (gi < 2) s5_load_group2(args, F, layer, g + 1, Gn);
        float hr0 = cr[gi][0], hi0 = cr[gi][1], hr1 = cr[gi][2], hi1 = cr[gi][3];
#pragma unroll 1
        for (int k = 0; k < 2; ++k) {
            const bf16x8 af = *(const LAS bf16x8*)(Gs + (32 * bb + 16 * k + tt) * 784 + (16 * g + 8 * hh) * 2);
            f32x16 X[4]; s5_tile(G.W, af, X, hr0, hi0, hr1, hi1);
#pragma unroll
            for (int nt = 0; nt < 4; ++nt)
#pragma unroll
                for (int g4 = 0; g4 < 4; ++g4) { u32x2 pk; pk.x = cvtpk(X[nt][4 * g4], X[nt][4 * g4 + 1]); pk.y = cvtpk(X[nt][4 * g4 + 2], X[nt][4 * g4 + 3]);
                    *(LAS u32x2*)(img + nt * 2048 + l31 * 64 + 8 * (2 * g4 + hh)) = pk; }
            LDS_WAIT(); asm volatile("" ::: "memory");
            f32x16 Y = zero16();
            const int i16 = F.lane & 15, q = i16 >> 2, pp = i16 & 3, blk = (F.lane >> 4) & 1;
#pragma unroll
            for (int nt = 0; nt < 4; ++nt)
#pragma unroll
                for (int s = 0; s < 2; ++s) {
                    const s16x4 lo = __builtin_bit_cast(s16x4, __builtin_amdgcn_ds_read_tr16_b64_v4i16((LAS s16x4*)(img + nt * 2048 + (16 * s + 8 * hh + q) * 64 + 8 * (4 * blk + pp))));
                    const s16x4 hi4 = __builtin_bit_cast(s16x4, __builtin_amdgcn_ds_read_tr16_b64_v4i16((LAS s16x4*)(img + nt * 2048 + (16 * s + 8 * hh + 4 + q) * 64 + 8 * (4 * blk + pp))));
                    const bf16x8 xa = __builtin_shufflevector(lo, hi4, 0, 1, 2, 3, 4, 5, 6, 7);
                    Y = mfma32(xa, G.cf[2 * nt + s], Y);
                }
            LDS_WAIT(); asm volatile("" ::: "memory");
            if (l31 < 16) {
                const int chn = 16 * g + l31; unsigned ur[16];
#pragma unroll
                for (int rg = 0; rg < 16; ++rg) ur[rg] = *(const LAS unsigned short*)(Gs + (32 * hh + 16 * k + rg) * 784 + chn * 2);
                asm volatile("" : "+v"(ur[0]), "+v"(ur[1]), "+v"(ur[2]), "+v"(ur[3]), "+v"(ur[4]), "+v"(ur[5]), "+v"(ur[6]), "+v"(ur[7]),
                                  "+v"(ur[8]), "+v"(ur[9]), "+v"(ur[10]), "+v"(ur[11]), "+v"(ur[12]), "+v"(ur[13]), "+v"(ur[14]), "+v"(ur[15]));
                float gv[16];
#pragma unroll
                for (int rg = 0; rg < 16; ++rg) gv[rg] = gelu_t(Y[rg] + G.dsk * __uint_as_float(ur[rg] << 16));
#pragma unroll
                for (int rg = 0; rg < 16; ++rg) *(LAS unsigned short*)(Gs + (32 * hh + 16 * k + rg) * 784 + chn * 2) = f2bf1(gv[rg]);
            }
        }
        if (sc == 255) { const size_t o = ((size_t)(layer * NBATCH + hh) * NG + g) * NP + l31;
            F.out[OUT_SRP + o] = hr0; F.out[OUT_SIP + o] = hi0; F.out[OUT_SRP + o + 32] = hr1; F.out[OUT_SIP + o + 32] = hi1; }
    }
    __syncthreads();
    glu_tile(args, F, layer, Gs, t0);
}

template <int TM, int KSTEPS, int UNR> DI void mini_mma(Frame& F, const bf16* A, int r0, const bf16* brow) {
    constexpr int K = KSTEPS * 16 * 8;
    const int l31 = F.lane & 31, hh = F.lane >> 5, w = F.wave, k0 = w * (KSTEPS * 16);
    f32x16 acc[TM / 32];
#pragma unroll
    for (int mt = 0; mt < TM / 32; ++mt) acc[mt] = zero16();
    const bf16* ap = A + (size_t)(r0 + l31) * K + k0 + 8 * hh; const bf16* bp = brow + k0 + 8 * hh;
#pragma unroll UNR
    for (int s = 0; s < KSTEPS; ++s) {
        const bf16x8 b = *(const bf16x8*)(bp + 16 * s);
#pragma unroll
        for (int mt = 0; mt < TM / 32; ++mt) { const bf16x8 a = *(const bf16x8*)(ap + (size_t)(32 * mt) * K + 16 * s); acc[mt] = mfma32(a, b, acc[mt]); }
    }
    LAS float* part = (LAS float*)F.lds + w * (TM * 33);
#pragma unroll
    for (int mt = 0; mt < TM / 32; ++mt)
#pragma unroll
        for (int rg = 0; rg < 16; ++rg) part[(32 * mt + crow(rg, hh)) * 33 + l31] = acc[mt][rg];
    __syncthreads();
}
template <int TM> DI void mini_sum8(Frame& F, int row, int c8, float (&v)[8]) {
    const LAS float* part = (const LAS float*)F.lds + row * 33 + 8 * c8;
    float pv[8][8];
#pragma unroll
    for (int w = 0; w < 8; ++w)
#pragma unroll
        for (int e = 0; e < 8; ++e) pv[w][e] = part[w * (TM * 33) + e];
#pragma unroll
    for (int w = 0; w < 8; w += 2)
        asm volatile("" : "+v"(pv[w][0]), "+v"(pv[w][1]), "+v"(pv[w][2]), "+v"(pv[w][3]), "+v"(pv[w][4]), "+v"(pv[w][5]), "+v"(pv[w][6]), "+v"(pv[w][7]),
                          "+v"(pv[w + 1][0]), "+v"(pv[w + 1][1]), "+v"(pv[w + 1][2]), "+v"(pv[w + 1][3]), "+v"(pv[w + 1][4]), "+v"(pv[w + 1][5]), "+v"(pv[w + 1][6]), "+v"(pv[w + 1][7]));
#pragma unroll
    for (int e = 0; e < 8; ++e) v[e] = ((pv[0][e] + pv[1][e]) + (pv[2][e] + pv[3][e])) + ((pv[4][e] + pv[5][e]) + (pv[6][e] + pv[7][e]));
}
DI void glu_sample_tile(const Args& args, Frame& F, int layer, int tile) {
    launder(F);
    const int mt = tile & 7, nt = tile >> 3, r0 = 32 * mt, n0 = 32 * nt;
    const bf16* gsm = (const bf16*)(F.ws + WS_GSMP);
    const bf16* wg = (const bf16*)(F.ws + WS_WGLU + (size_t)layer * WGLU_STRIDE);
    mini_mma<32, 3, 3>(F, gsm, r0, wg + (size_t)(n0 + (F.lane & 31)) * BW);
    if (F.tid < 128) { const int row = F.tid >> 2, c8 = F.tid & 3, c0 = n0 + 8 * c8;
        float v[8]; mini_sum8<32>(F, row, c8, v);
        const u32x4 rw = *(const u32x4*)(gsm + (size_t)(r0 + row) * BW + c0);
        const float* bg = args.in[20] + (size_t)layer * BW + c0; const f32x4 b0 = *(const f32x4*)bg, b1 = *(const f32x4*)(bg + 4);
        const float gv[8] = {__uint_as_float(rw.x << 16), __uint_as_float(rw.x & 0xffff0000u), __uint_as_float(rw.y << 16), __uint_as_float(rw.y & 0xffff0000u),
                             __uint_as_float(rw.z << 16), __uint_as_float(rw.z & 0xffff0000u), __uint_as_float(rw.w << 16), __uint_as_float(rw.w & 0xffff0000u)};
        const float bb[8] = {b0.x, b0.y, b0.z, b0.w, b1.x, b1.y, b1.z, b1.w};
        float o[8];
#pragma unroll
        for (int e2 = 0; e2 < 8; ++e2) o[e2] = gv[e2] * sigmoid_f(v[e2] + bb[e2]);
        store8_bf16((bf16*)(F.ws + WS_MIX) + (size_t)(MP + r0 + row) * DM + AW + c0, o); }
    __syncthreads();
}

DI void mini_in_tile(const Args& args, Frame& F, int layer, int tile) {
    launder(F);
    const int mt = tile & 3, nt = tile >> 2, r0 = MP + 64 * mt, n0 = 32 * nt;
    const bf16* W = (const bf16*)(F.ws + WS_W + (size_t)layer * W_STRIDE + W_IN);
    float rstd; f32x4 t0 = (f32x4){1.f, 0.f, 1.f, 0.f}, t1 = t0;
    { const int row = (F.tid & 255) >> 2, c8 = F.tid & 3, grow = r0 + row, c0 = n0 + 8 * c8, hd = (c0 - O_Q) & 63;
      rstd = row_rstd((const float*)(F.ws + WS_RSS), grow);
      if (c0 >= O_Q && c0 < O_VV && hd < 16) { const f32x4* rp = (const f32x4*)((const f32x2*)(F.ws + WS_ROPE) + (size_t)row_pos(grow) * 8 + (hd >> 1)); t0 = rp[0]; t1 = rp[1]; } }
    mini_mma<64, 8, 8>(F, (const bf16*)(F.ws + WS_XB), r0, W + (size_t)(n0 + (F.lane & 31)) * DM);
    if (F.tid < 256) { const int row = F.tid >> 2, c8 = F.tid & 3, grow = r0 + row, c0 = n0 + 8 * c8;
        float v[8]; mini_sum8<64>(F, row, c8, v);
#pragma unroll
        for (int e = 0; e < 8; ++e) v[e] *= rstd;
        epi_in_apply(grow, c0, v, t0, t1, (bf16*)(F.ws + WS_PROJ), F.out, layer); }
    __syncthreads();
}
DI void mini_res_tile(const Args& args, Frame& F, int layer, int tile, const bf16* A, int K, const bf16* W, int first, int wf32) {
    launder(F);
    const int mt = tile & 7, nt = tile >> 3, r0 = MP + 32 * mt, n0 = 32 * nt;
    float* X = (float*)(F.ws + WS_X); bf16* XBp = (bf16*)(F.ws + WS_XB);
    f32x4 a0 = (f32x4){0.f, 0.f, 0.f, 0.f}, a1 = a0;
    { const int row = (F.tid & 127) >> 2, c8 = F.tid & 3, grow = r0 + row, c0 = n0 + 8 * c8;
      if (first) { const float* src = args.in[1] + (size_t)(grow - MP) * DM; a0 = *(const f32x4*)(src + c0); a1 = *(const f32x4*)(src + c0 + 4); }
      else { const u32x4 rw = *(const u32x4*)(XBp + (size_t)grow * DM + c0);
          a0 = (f32x4){__uint_as_float(rw.x << 16), __uint_as_float(rw.x & 0xffff0000u), __uint_as_float(rw.y << 16), __uint_as_float(rw.y & 0xffff0000u)};
          a1 = (f32x4){__uint_as_float(rw.z << 16), __uint_as_float(rw.z & 0xffff0000u), __uint_as_float(rw.w << 16), __uint_as_float(rw.w & 0xffff0000u)}; } }
    if (K == DM) mini_mma<32, 8, 8>(F, A, r0, W + (size_t)(n0 + (F.lane & 31)) * K); else mini_mma<32, 22, 22>(F, A, r0, W + (size_t)(n0 + (F.lane & 31)) * K);
    if (F.tid < 128) { const int row = F.tid >> 2, c8 = F.tid & 3, grow = r0 + row, c0 = n0 + 8 * c8;
        float v[8]; mini_sum8<32>(F, row, c8, v);
        float ss = 0.f;
#pragma unroll
        for (int e = 0; e < 4; ++e) { v[e] += a0[e]; v[4 + e] += a1[e]; }
#pragma unroll
        for (int e = 0; e < 8; ++e) ss += v[e] * v[e];
        if (wf32) { *(f32x4*)(X + (size_t)grow * DM + c0) = (f32x4){v[0], v[1], v[2], v[3]}; *(f32x4*)(X + (size_t)grow * DM + c0 + 4) = (f32x4){v[4], v[5], v[6], v[7]}; }
        store8_bf16(XBp + (size_t)grow * DM + c0, v);
        ss += __shfl_xor(ss, 1); ss += __shfl_xor(ss, 2);
        if (c8 == 0) ((float*)(F.ws + WS_RSS))[(size_t)grow * 32 + nt] = ss; }
    __syncthreads();
}
DI void mini_up_tile(const Args& args, Frame& F, int layer, int tile) {
    launder(F);
    const int mt = tile & 3, nt = tile >> 2, r0 = MP + 64 * mt, j0 = 16 * nt, l31 = F.lane & 31;
    const bf16* W = (const bf16*)(F.ws + WS_W + (size_t)layer * W_STRIDE + W_UP);
    const int jl = j0 + (l31 & 15), prow = 256 * (jl >> 7) + 128 * (l31 >> 4) + (jl & 127);
    mini_mma<64, 8, 8>(F, (const bf16*)(F.ws + WS_XB), r0, W + (size_t)prow * DM);
    LAS float* hbuf = (LAS float*)F.lds + 8 * (64 * 33);
    if (F.tid < 256) { const int row = F.tid >> 2, c8 = F.tid & 3, grow = r0 + row;
        float v[8]; mini_sum8<64>(F, row, c8, v);
        const float rstd = row_rstd((const float*)(F.ws + WS_RSS), grow);
#pragma unroll
        for (int e = 0; e < 8; ++e) { v[e] *= rstd; hbuf[row * 33 + 8 * c8 + e] = v[e]; }
        const int rs = grow - MP, sb = rs >> 3, t = rs & 7, cl = (c8 >> 1) * DFF + j0 + 8 * (c8 & 1);
        if (t >= STOK - 2) { float* sd = F.out + OUT_FCS + (((size_t)layer * SBATCH + sb) * 2 + (t - (STOK - 2))) * DFF2 + cl;
            *(f32x4*)sd = (f32x4){v[0], v[1], v[2], v[3]}; *(f32x4*)(sd + 4) = (f32x4){v[4], v[5], v[6], v[7]}; } }
    __syncthreads();
    if (F.tid < 128) { const int row = F.tid >> 1, jc = F.tid & 1, grow = r0 + row, rs = grow - MP, sb = rs >> 3, t = rs & 7;
        const float* cw = args.in[24] + (size_t)layer * 3 * DFF2; const float* cb = args.in[25] + (size_t)layer * DFF2;
        const float* sbuf = args.in[6] + ((size_t)layer * SBATCH + sb) * 2 * DFF2;
        float o[8];
#pragma unroll
        for (int e = 0; e < 8; ++e) { const int j = j0 + 8 * jc + e; float hc[2];
#pragma unroll
            for (int half = 0; half < 2; ++half) { const int col = half * DFF + j, lc = 16 * half + 8 * jc + e; float a = cb[col];
#pragma unroll
                for (int tap = 0; tap < 3; ++tap) { const int back = 2 - tap; const float hv = (t - back >= 0) ? hbuf[(row - back) * 33 + lc] : sbuf[(size_t)(t - back + 2) * DFF2 + col]; a += cw[(size_t)tap * DFF2 + col] * hv; }
                hc[half] = a; }
            o[e] = gelu_t(hc[0]) * hc[1]; }
        store8_bf16((bf16*)(F.ws + WS_A2) + (size_t)grow * DFF + j0 + 8 * jc, o); }
    __syncthreads();
}

DI void final_norm(const Args& args, Frame& F) {
    launder(F);
    const bf16* XB = (const bf16*)(F.ws + WS_XB); const float* rss = (const float*)(F.ws + WS_RSS); const float* fg = args.in[27];
    const int gw = F.bid * NWAVES + F.wave, NGW = F.G * NWAVES;
    for (int row = gw; row < MR; row += NGW) { const float rstd = row_rstd(rss, row);
        float* o = row < MP ? F.out + OUT_YP + (size_t)row * DM : F.out + OUT_YS + (size_t)(row - MP) * DM;
#pragma unroll
        for (int jq = 0; jq < 2; ++jq) { const u32x4 rw = ((const u32x4*)(XB + (size_t)row * DM))[F.lane + 64 * jq]; const f32x4 g0 = ((const f32x4*)fg)[2 * (F.lane + 64 * jq)], g1 = ((const f32x4*)fg)[2 * (F.lane + 64 * jq) + 1];
            ((f32x4*)o)[2 * (F.lane + 64 * jq)] = (f32x4){__uint_as_float(rw.x << 16) * rstd * g0.x, __uint_as_float(rw.x & 0xffff0000u) * rstd * g0.y, __uint_as_float(rw.y << 16) * rstd * g0.z, __uint_as_float(rw.y & 0xffff0000u) * rstd * g0.w};
            ((f32x4*)o)[2 * (F.lane + 64 * jq) + 1] = (f32x4){__uint_as_float(rw.z << 16) * rstd * g1.x, __uint_as_float(rw.z & 0xffff0000u) * rstd * g1.y, __uint_as_float(rw.w << 16) * rstd * g1.z, __uint_as_float(rw.w & 0xffff0000u) * rstd * g1.w}; } }
}

constexpr int N_PHASES = 26;
#ifndef REP_P2
#define REP_P2 1
#endif
#ifndef REP_P1
#define REP_P1 1
#endif
#ifndef REP_AS
#define REP_AS 1
#endif
#ifndef PROBE_MODE
#define PROBE_MODE 0
#endif
#ifndef REP_P4
#define REP_P4 1
#endif
#ifndef REP_P6
#define REP_P6 1
#endif
#ifndef REP_S2
#define REP_S2 1
#endif
#ifndef REP_MG
#define REP_MG 1
#endif
#ifndef REP_AP
#define REP_AP 1
#endif
#ifndef REP_S1
#define REP_S1 1
#endif
#ifndef REP_SG
#define REP_SG 1
#endif
#ifndef REP_P5
#define REP_P5 1
#endif
#ifndef REP_CV
#define REP_CV 1
#endif
#ifndef REP_PRO
#define REP_PRO 1
#endif
#ifndef REP_P3
#define REP_P3 1
#endif

__global__ void __launch_bounds__(NTHR, 2) hymba_fwd(Args args) {
    extern __shared__ __attribute__((aligned(16))) unsigned char lds_raw[];
    Frame F;
    F.lds = (LAS unsigned char*)lds_raw;
    F.tid = threadIdx.x; F.lane = F.tid & 63; F.wave = __builtin_amdgcn_readfirstlane(F.tid >> 6); F.G = gridDim.x; F.bid = blockIdx.x;
    F.out = args.out; F.ws = args.ws;
    volatile LAS unsigned* MISC = (volatile LAS unsigned*)(F.lds + MISC_OFF);
    for (int u = F.tid; u < (LDS_BYTES - LDSCTL_OFF) / 4; u += NTHR) ((LAS unsigned*)(F.lds + LDSCTL_OFF))[u] = 0u;
    __syncthreads();
    unsigned* ctl = (unsigned*)(F.ws + WS_CTL);
    XcdBarrier bar = xcd_barrier_post(ctl + CW_BAR, MISC + 8);
    const int lo = args.ph_lo, hi = args.ph_hi;
#define IN(k) (lo <= (k) && (k) < hi)
#if defined(STAMP_A)
#define SEAM(k) do { if (IN(k) && IN((k) + 1)) { xcd_barrier(bar); if (F.bid == 0 && F.tid == 0) ((unsigned long long*)(F.ws + WS_CTL + 524288))[(k) + 1] = __builtin_amdgcn_s_memrealtime(); } } while (0)
#else
#define SEAM(k) do { if (IN(k) && IN((k) + 1)) xcd_barrier(bar); } while (0)
#endif

    #ifndef DIS_PRO
    for (int rep_ = 0; rep_ < REP_PRO; ++rep_) if (IN(0)) { if (rep_) { __syncthreads(); } prologue(args, F); }
#endif
    SEAM(0);

    for (int l = 0; l < DEPTH; ++l) {
        const int pb = 1 + 6 * l;
#ifndef DIS_G1
        for (int rep_ = 0; rep_ < REP_P1; ++rep_) if (IN(pb + 0)) { if (rep_) { __syncthreads(); } const int ll = launder_i(l); unsigned char* wl = F.ws + WS_W + (size_t)ll * W_STRIDE; (void)wl;
            pg8::Gemm g{(const bf16*)(F.ws + WS_XB), (const bf16*)(wl + W_IN), MP, INW, DM}; pg8::StaticOrder S; S.init(MP, INW, launder_i(F.G), launder_i(F.bid));
            build_rstd_table(F, S, (const float*)(F.ws + WS_RSS));
            EpiIn E{(bf16*)(F.ws + WS_PROJ), (const LAS float*)(F.lds + RSTD_OFF), (const f32x2*)(F.ws + WS_ROPE), F.out, ll};
            pg8::gemm_phase<EpiIn, pg8::StaticOrder, true, true>(F.lds, g, S, E, launder_i(F.wave));
            for (int t = F.bid; t < 256; t += F.G) mini_in_tile(args, F, ll, t);
        }
#endif
        SEAM(pb + 0);
#ifndef DIS_P2
        for (int rep_ = 0; rep_ < REP_P2; ++rep_) if (IN(pb + 1)) { if (rep_) { __syncthreads(); } const int ll = launder_i(l); unsigned char* wl = F.ws + WS_W + (size_t)ll * W_STRIDE; (void)wl;
#define DEAL(start, count) for (int gi_ = (start) + (((F.bid - (start)) % F.G) + F.G) % F.G, u = gi_ - (start); gi_ < (start) + (count); gi_ += F.G, u += F.G)
            if (F.bid & 1) {
                attn_prompt_phase(F, F.bid, 1152, F.G);
                DEAL(0, 576) attn_sample_unit(args, F, ll, u);
            } else {
                DEAL(0, 576) attn_sample_unit(args, F, ll, u);
                attn_prompt_phase(F, F.bid, 1152, F.G);
            }
            {   unsigned* qc = ctl + CW_Q + 64 * ll;
                volatile LAS unsigned* qs = MISC + 10;
                if (threadIdx.x == 0) qs[0] = xb_add(qc, 1u);
                __syncthreads();
                unsigned cur = qs[0];
                __syncthreads();
                while (cur < 448u) {
                    if (threadIdx.x == 0) qs[0] = xb_add(qc, 1u);
                    const int tk = __builtin_amdgcn_readfirstlane((int)cur);
                    if (tk < 128) sgu_prompt_unit(args, F, ll, tk);
                    else if (tk < 320) { const int u = tk - 128; s5_pass1_unit(F, ll, u / NG, u % NG); }
                    else if (tk < 416) s5_sample_unit(args, F, ll, tk - 320);
                    else sgu_sample_unit(args, F, ll, tk - 416);
                    cur = qs[0];
                    __syncthreads();
                }
            }
#undef DEAL
        }
#endif
        SEAM(pb + 1);
#ifndef DIS_P3
        for (int rep_ = 0; rep_ < REP_P3; ++rep_) if (IN(pb + 2)) { if (rep_) { __syncthreads(); } const int ll = launder_i(l); unsigned char* wl = F.ws + WS_W + (size_t)ll * W_STRIDE; (void)wl;
#ifndef DIS_U_S2
            for (int r2_ = 0; r2_ < REP_S2; ++r2_) for (int u = F.bid; u < 256; u += F.G) s5_pass2_unit(args, F, ll, u);
#endif
#if defined(STAMP_A)
            if (l == 1 && F.bid == 0 && F.wave == 0) ((unsigned long long*)(F.ws + WS_CTL + 524288))[40] = __builtin_amdgcn_s_memrealtime();
#endif
            for (int u = F.bid; u < 96; u += F.G) glu_sample_tile(args, F, ll, u);
#ifndef DIS_U_MG
            for (int r2_ = 0; r2_ < REP_MG; ++r2_) attn_merge(F);
            attn_sample_merge(F);
#endif
#if defined(STAMP_A)
            if (l == 1 && F.bid == 0 && F.wave == 0) ((unsigned long long*)(F.ws + WS_CTL + 524288))[41] = __builtin_amdgcn_s_memrealtime();
#endif

        }
#endif
        SEAM(pb + 2);
#ifndef DIS_G4
        for (int rep_ = 0; rep_ < REP_P4; ++rep_) if (IN(pb + 3)) { if (rep_) { __syncthreads(); } const int ll = launder_i(l); unsigned char* wl = F.ws + WS_W + (size_t)ll * W_STRIDE; (void)wl;
            pg8::Gemm g{(const bf16*)(F.ws + WS_MIX), (const bf16*)(wl + W_OUT), MP, DM, DM}; pg8::StaticOrder S; S.init(MP, DM, launder_i(F.G), launder_i(F.bid));
            EpiRes E{args.in[0], args.in[1], (float*)(F.ws + WS_X), (bf16*)(F.ws + WS_XB), (float*)(F.ws + WS_RSS), ll == 0 ? 1 : 0, rep_ + 1 < REP_P4 ? 1 : 0, 0};
            if (rep_ + 1 < REP_P4) { pg8::gemm_phase<EpiRes, pg8::StaticOrder, true, true>(F.lds, g, S, E, launder_i(F.wave)); continue; }
            pg8::gemm_phase<EpiRes, pg8::StaticOrder, true, true>(F.lds, g, S, E, launder_i(F.wave));
            for (int t = F.bid; t < 256; t += F.G) mini_res_tile(args, F, ll, t, (const bf16*)(F.ws + WS_MIX), DM, (const bf16*)(wl + W_OUT), ll == 0 ? 1 : 0, 0);
        }
#endif
        SEAM(pb + 3);
#ifndef DIS_G5
        for (int rep_ = 0; rep_ < REP_P5; ++rep_) if (IN(pb + 4)) { if (rep_) { __syncthreads(); } const int ll = launder_i(l); unsigned char* wl = F.ws + WS_W + (size_t)ll * W_STRIDE;
            pg8::Gemm g{(const bf16*)(F.ws + WS_XB), (const bf16*)(wl + W_UP), UP_PANELS * 256, DFF2, DM}; UpOrder S; S.init(UP_PANELS * 256, DFF2, launder_i(F.G), launder_i(F.bid));
            build_rstd_table_up(F, S, (const float*)(F.ws + WS_RSS), args.in[24] + (size_t)ll * 3 * DFF2, args.in[25] + (size_t)ll * DFF2);
            EpiUpConv E{(bf16*)(F.ws + WS_A2), (const LAS float*)(F.lds + RSTD_OFF), (LAS float*)(F.lds + XCH_OFF), args.in[24] + (size_t)ll * 3 * DFF2, args.in[25] + (size_t)ll * DFF2, args.in[6], F.out, ll, 0};
#if PROBE_MODE == 1
            if (rep_ + 1 < REP_P5) { EpiUpConv E1 = E; E1.mode = 1; pg8::gemm_phase<EpiUpConv, UpOrder, true, true>(F.lds, g, S, E1, launder_i(F.wave)); continue; }
#elif PROBE_MODE == 2
            if (rep_ + 1 < REP_P5) { EpiStoreOnly ES{(bf16*)(F.ws + WS_A2)}; pg8::gemm_phase<EpiStoreOnly, UpOrder, true, true>(F.lds, g, S, ES, launder_i(F.wave)); continue; }
#else
            if (rep_ + 1 < REP_P5) { EpiNull EN{(float*)(F.ws + WS_OPS)}; pg8::gemm_phase<EpiNull, UpOrder, true, true>(F.lds, g, S, EN, launder_i(F.wave)); continue; }
#endif
            pg8::gemm_phase<EpiUpConv, UpOrder, true, true>(F.lds, g, S, E, launder_i(F.wave));
            { const int heavy = (UP_PANELS * 22) % F.G, nfree = F.G - SMP_UNITS - heavy;
              if (ll + 1 < DEPTH && rep_ == 0) { if (heavy > 0 && nfree >= 16) { if (F.bid >= heavy && F.bid < F.G - SMP_UNITS) convert_layer_weights(args, F, ll + 1, heavy, nfree); } else convert_layer_weights(args, F, ll + 1, 0, F.G); } }
            { SmpOrder SS{launder_i(F.G), launder_i(F.bid)};
              const int pre_ = (F.bid >= F.G - 22 && F.bid >= (UP_PANELS * 22) % F.G && (UP_PANELS * 22) % F.G > 0) ? 1 : 0;
              EpiUpSample ES{(bf16*)(F.ws + WS_A2), (LAS float*)(F.lds + RSTD_OFF) + (pre_ ? 5 * 256 : 0), (const float*)(F.ws + WS_RSS), args.in[24] + (size_t)ll * 3 * DFF2, args.in[25] + (size_t)ll * DFF2, args.in[6], F.out, ll, pre_};
              pg8::gemm_phase<EpiUpSample, SmpOrder, false, true>(F.lds, g, SS, ES, launder_i(F.wave)); }
        }
#endif
        SEAM(pb + 4);
#ifndef DIS_G6
        for (int rep_ = 0; rep_ < REP_P6; ++rep_) if (IN(pb + 5)) { if (rep_) { __syncthreads(); } const int ll = launder_i(l); unsigned char* wl = F.ws + WS_W + (size_t)ll * W_STRIDE; (void)wl;
            pg8::Gemm g{(const bf16*)(F.ws + WS_A2), (const bf16*)(wl + W_DOWN), MP, DM, DFF}; pg8::StaticOrder S; S.init(MP, DM, launder_i(F.G), launder_i(F.bid));
            EpiRes E{args.in[0], args.in[1], (float*)(F.ws + WS_X), (bf16*)(F.ws + WS_XB), (float*)(F.ws + WS_RSS), 0, rep_ + 1 < REP_P6 ? 1 : 0, 0};
            if (rep_ + 1 < REP_P6) { pg8::gemm_phase<EpiRes, pg8::StaticOrder, true, true>(F.lds, g, S, E, launder_i(F.wave)); continue; }
            pg8::gemm_phase<EpiRes, pg8::StaticOrder, true, true>(F.lds, g, S, E, launder_i(F.wave));
            for (int t = F.bid; t < 256; t += F.G) mini_res_tile(args, F, ll, t, (const bf16*)(F.ws + WS_A2), DFF, (const bf16*)(wl + W_DOWN), 0, 0);
        }
#endif
        SEAM(pb + 5);
    }
    if (IN(25)) { final_norm(args, F); }
#if defined(STAMP_A)
    if (F.bid == 0) { const unsigned long long* st = (const unsigned long long*)(F.ws + WS_CTL + 524288);
        const float tus = (float)(st[STAMP_B] - st[STAMP_A]) * 0.01f, s = 1.0f + tus / (float)(STAMP_REF);
        for (int i = F.tid; i < DEPTH * NBATCH * NG * NP; i += NTHR) F.out[OUT_SRP + i] *= s; }
#endif
#undef IN
#undef SEAM
}

#ifndef MK_SPLIT
#define MK_SPLIT 0
#endif
extern "C" void kernel_launch(void* const* d_in, const int* in_sizes, int n_in, void* d_out, int out_size, void* d_ws, size_t ws_size, hipStream_t stream) {
    static int grid = 0;
    if (grid == 0) {
        if (n_in != 28 || (size_t)out_size != OUT_END || ws_size < WS_END) { fprintf(stderr, "kernel_launch: unexpected shapes: n_in %d out %d (want %zu) ws %zu (want %zu)\n", n_in, out_size, (size_t)OUT_END, ws_size, (size_t)WS_END); grid = -1; return; }
        int dev = 0, cus = 0, per_cu = 0;
        if (hipGetDevice(&dev) != hipSuccess || hipDeviceGetAttribute(&cus, hipDeviceAttributeMultiprocessorCount, dev) != hipSuccess) { grid = -1; return; }
        if (hipFuncSetAttribute((const void*)hymba_fwd, hipFuncAttributeMaxDynamicSharedMemorySize, LDS_BYTES) != hipSuccess) { fprintf(stderr, "kernel_launch: hipFuncSetAttribute failed\n"); grid = -1; return; }
        if (hipOccupancyMaxActiveBlocksPerMultiprocessor(&per_cu, (const void*)hymba_fwd, NTHR, LDS_BYTES) != hipSuccess || per_cu < 1) { fprintf(stderr, "kernel_launch: occupancy query says %d\n", per_cu); }
        (void)hipGetLastError();
        grid = cus;
    }
    if (grid < 0) return;
    (void)hipMemsetAsync((char*)d_ws + WS_CTL, 0, CTL_ZERO_BYTES, stream);
    Args a{};
    for (int i = 0; i < 28; ++i) a.in[i] = (const float*)d_in[i];
    a.out = (float*)d_out; a.ws = (unsigned char*)d_ws;
#if MK_SPLIT
    for (int p = 0; p < N_PHASES; ++p) { a.ph_lo = p; a.ph_hi = p + 1; hipLaunchKernelGGL(hymba_fwd, dim3(grid), dim3(NTHR), LDS_BYTES, stream, a); }
#else
    a.ph_lo = 0; a.ph_hi = N_PHASES;
    hipLaunchKernelGGL(hymba_fwd, dim3(grid), dim3(NTHR), LDS_BYTES, stream, a);
#endif
}
```

```cpp
#include <hip/hip_runtime.h>
#include <cstdio>
#include <cstdint>

namespace pg8 {
#define PG8_LAS __attribute__((address_space(3)))
typedef unsigned short bf16_t;
typedef short bf16x8 __attribute__((ext_vector_type(8)));
typedef float f32x4 __attribute__((ext_vector_type(4)));
typedef unsigned u32x4 __attribute__((ext_vector_type(4)));
constexpr int BM = 256, BK = 64, HALF = 128, HTB = HALF * BK * 2  , STAGE_BYTES = 8 * HTB, NXCD = 8, WGM = 8;

__host__ __device__ __forceinline__ int lds_byte(int r, int c) { const int st = (r >> 4) * 2 + (c >> 5), rr = r & 15, cc = c & 31, ob = rr * 64 + cc * 2; return st * 1024 + (ob ^ (((ob >> 9) & 1) << 5)); }
__host__ __device__ __forceinline__ void stage_rc(int b, int& R, int& C) { const int st = b / 1024, sb = b % 1024, swz = sb ^ (((sb >> 9) & 1) << 5); R = (st >> 1) * 16 + swz / 64; C = (st & 1) * 32 + (swz % 64) / 2; }
__host__ __device__ __forceinline__ int perm32(int rho) { const int n = rho >> 4, i = rho & 15; return 8 * (i >> 2) + 4 * n + (i & 3); }

struct Unit { int pm, pn; };
struct Gemm { const bf16_t* A; const bf16_t* Bt; int M, N, K; };

struct StaticOrder {
    int nM, nN, nwg, G, c;
    __host__ __device__ void init(int M, int N, int G_, int c_) { nM = M / BM; nN = N / BM; nwg = nM * nN; G = G_; c = c_; }
    __host__ __device__ bool next(int i, Unit& u) const {
        const long L = (long)i * G + c; if (L >= nwg) return false;
        int wgid = (int)L; { const int q = nwg / NXCD, r = nwg % NXCD, xcd = wgid % NXCD, off = wgid / NXCD; wgid = (xcd < r ? xcd * (q + 1) : r * (q + 1) + (xcd - r) * q) + off; }
        const int nig = WGM * nN, gid = wgid / nig, fm = gid * WGM, gsz = (nM - fm) < WGM ? (nM - fm) : WGM;
        u.pm = fm + ((wgid % nig) % gsz); u.pn = (wgid % nig) / gsz; return true;
    }
    __device__ __forceinline__ long a_off(const Unit& u, long tstep) const { return (long)u.pm * tstep; }
    __device__ __forceinline__ void a_ready(const Unit&) const {}
    __device__ __forceinline__ void done(const Unit&) const {}
};

__device__ __forceinline__ unsigned cvt_pk_bf16(float lo, float hi) { unsigned r; asm volatile("v_cvt_pk_bf16_f32 %0, %1, %2" : "=v"(r) : "v"(lo), "v"(hi)); return r; }
typedef float f32x2 __attribute__((ext_vector_type(2)));
__device__ __forceinline__ f32x2 gelu_pk(f32x2 v) {
    const f32x2 av = __builtin_elementwise_abs(v), d = av * 0.2316418882f + 1.0f;
    f32x2 t; t.x = __builtin_amdgcn_rcpf(d.x); t.y = __builtin_amdgcn_rcpf(d.y);
    f32x2 q = t * 0.5307027145f + (-0.7265760135f); q = q * t + 0.7107068705f; q = q * t + (-0.142248368f); q = q * t + 0.127414796f; q = q * t;
    const f32x2 s = (v * v) * (-0.72134752044f);
    f32x2 e; e.x = __builtin_amdgcn_exp2f(s.x); e.y = __builtin_amdgcn_exp2f(s.y);
    const f32x2 m = v * (q * e), r = v - m;
    f32x2 o; o.x = v.x < 0.f ? m.x : r.x; o.y = v.y < 0.f ? m.y : r.y; return o;
}

template <class Epi, class Sched, bool ALIGN_EPI = false, bool SP2 = false>
__device__ __forceinline__ void gemm_phase(PG8_LAS unsigned char* lds, const Gemm g, const Sched& S, const Epi& E, const int wid_in) {
    int lane_ = (int)__builtin_amdgcn_mbcnt_hi(~0u, __builtin_amdgcn_mbcnt_lo(~0u, 0u)); asm volatile("" : "+v"(lane_));
    const int wid = wid_in, lane = lane_, tid = wid * 64 + lane, wr = wid >> 2, wc = wid & 3, fr = lane & 15, fq = lane >> 4;
    const int K = g.K, nt = K / BK;
    unsigned voffA[2], voffB[2];
#pragma unroll
    for (int i = 0; i < 2; ++i) { int R, C; stage_rc(tid * 16 + i * 8192, R, C); const int Rb = Epi::PERM ? ((R & ~31) + perm32(R & 31)) : R;
        const int Ra = Epi::APERM ? ((R & ~63) | (4 * (R & 15) + ((R >> 4) & 3))) : R;
        voffA[i] = (unsigned)(Ra * K + C) * 2u; voffB[i] = (unsigned)(Rb * K + C) * 2u; }
    const size_t kstep = (size_t)(BK * 2);
    const size_t hstep = (size_t)HALF * K * 2;
    const size_t tstep = 2 * hstep;
    const unsigned ldsw = (unsigned)wid * 1024u;
    const int aoff = lds_byte(wr * 64 + fr, fq * 8), boff = lds_byte(wc * 32 + fr, fq * 8);
#define PG8_SA(b, h) (((b) * 2 + (h)) * HTB)
#define PG8_SB(b, h) ((4 + (b) * 2 + (h)) * HTB)
#define PG8_STAGE(bufoff, gbase, voff) do { _Pragma("unroll") for (int _i = 0; _i < 2; ++_i) \
        __builtin_amdgcn_global_load_lds((const unsigned*)((const char*)(gbase) + (voff)[_i]), (PG8_LAS unsigned*)(lds + (bufoff) + ldsw + _i * 8192), 16, 0, 0); } while (0)
#define PG8_LDA(dst, b, h) do { _Pragma("unroll") for (int m = 0; m < 4; ++m) _Pragma("unroll") for (int k = 0; k < 2; ++k) dst[m][k] = *(const PG8_LAS bf16x8*)(lds + PG8_SA(b, h) + aoff + m * 2048 + k * 1024); } while (0)
#define PG8_LDB(dst, b, h) do { _Pragma("unroll") for (int n = 0; n < 2; ++n) _Pragma("unroll") for (int k = 0; k < 2; ++k) dst[n][k] = *(const PG8_LAS bf16x8*)(lds + PG8_SB(b, h) + boff + n * 2048 + k * 1024); } while (0)
#define PG8_MMA(ai, bj, At, Bt) do { __builtin_amdgcn_s_setprio(1); _Pragma("unroll") for (int m = 0; m < 4; ++m) _Pragma("unroll") for (int n = 0; n < 2; ++n) _Pragma("unroll") for (int k = 0; k < 2; ++k) \
        acc[ai][bj][m][n] = __builtin_amdgcn_mfma_f32_16x16x32_bf16(Bt[n][k], At[m][k], acc[ai][bj][m][n], 0, 0, 0); __builtin_amdgcn_s_setprio(0); } while (0)
#define PG8_WAIT_V(n) asm volatile("s_waitcnt vmcnt(" #n ")" ::: "memory")
#define PG8_WAIT_L(n) asm volatile("s_waitcnt lgkmcnt(" #n ")" ::: "memory")
#define PG8_BAR __builtin_amdgcn_s_barrier()
#define PG8_SCHED __builtin_amdgcn_sched_barrier(0)
    Unit cur, nxt; int ui = 0;
    if (!S.next(0, cur)) return;
    f32x4 acc[2][2][4][2];
#pragma unroll
    for (int a = 0; a < 2; ++a)
#pragma unroll
        for (int b = 0; b < 2; ++b)
#pragma unroll
            for (int m = 0; m < 4; ++m)
#pragma unroll
                for (int n = 0; n < 2; ++n) acc[a][b][m][n] = (f32x4){0.f, 0.f, 0.f, 0.f};
    bf16x8 At[4][2], B0[2][2], B1[2][2];
    const char* cA = (const char*)g.A + S.a_off(cur, (long)tstep); const char* cB = (const char*)g.Bt + (size_t)cur.pn * tstep;
    S.a_ready(cur);
    if constexpr (SP2) {
        PG8_STAGE(PG8_SB(0, 0), cB, voffB); PG8_STAGE(PG8_SB(0, 1), cB + hstep, voffB); PG8_STAGE(PG8_SA(0, 0), cA, voffA); PG8_STAGE(PG8_SA(0, 1), cA + hstep, voffA);
        if (wr == 1) PG8_BAR;
        PG8_WAIT_V(2); PG8_BAR;
        PG8_STAGE(PG8_SB(1, 0), cB + kstep, voffB); PG8_STAGE(PG8_SA(1, 0), cA + kstep, voffA); PG8_STAGE(PG8_SB(1, 1), cB + hstep + kstep, voffB);
        PG8_WAIT_V(6); PG8_BAR;
    } else {
        PG8_STAGE(PG8_SB(0, 0), cB, voffB); PG8_STAGE(PG8_SA(0, 0), cA, voffA); PG8_STAGE(PG8_SB(0, 1), cB + hstep, voffB); PG8_STAGE(PG8_SA(0, 1), cA + hstep, voffA);
        if (wr == 1) PG8_BAR;
        PG8_WAIT_V(4); PG8_BAR;
        PG8_STAGE(PG8_SB(1, 0), cB + kstep, voffB); PG8_STAGE(PG8_SA(1, 0), cA + kstep, voffA); PG8_STAGE(PG8_SB(1, 1), cB + hstep + kstep, voffB);
        PG8_WAIT_V(6); PG8_BAR;
    }
    for (;;) {
        const bool has_next = S.next(ui + 1, nxt);
        const char* nA = has_next ? (const char*)g.A + S.a_off(nxt, (long)tstep) : cA; const char* nB = has_next ? (const char*)g.Bt + (size_t)nxt.pn * tstep : cB;
        for (int t = 0; t < nt; t += 2) {
            const bool last = (t == nt - 2);
            const char* a1 = cA + (size_t)(t + 1) * kstep;
            const char* a2 = last ? nA : cA + (size_t)(t + 2) * kstep; const char* b2 = last ? nB : cB + (size_t)(t + 2) * kstep;
            const char* a3 = a2 + kstep; const char* b3 = b2 + kstep;
            if (last && has_next) S.a_ready(nxt);
            if constexpr (SP2) {
            PG8_LDB(B0, 0, 0); PG8_LDB(B1, 0, 1); PG8_SCHED; PG8_LDA(At, 0, 0); PG8_STAGE(PG8_SA(1, 1), a1 + hstep, voffA);
            PG8_WAIT_V(8); PG8_WAIT_L(0); PG8_BAR; PG8_MMA(0, 0, At, B0); PG8_MMA(0, 1, At, B1); PG8_BAR; PG8_SCHED;
            PG8_LDA(At, 0, 1); PG8_STAGE(PG8_SB(0, 0), b2, voffB); PG8_STAGE(PG8_SB(0, 1), b2 + hstep, voffB); PG8_STAGE(PG8_SA(0, 0), a2, voffA);
            PG8_WAIT_V(8); PG8_WAIT_L(0); PG8_BAR; PG8_MMA(1, 0, At, B0); PG8_MMA(1, 1, At, B1); PG8_BAR; PG8_SCHED;
            PG8_LDB(B0, 1, 0); PG8_LDB(B1, 1, 1); PG8_SCHED; PG8_LDA(At, 1, 0); PG8_STAGE(PG8_SA(0, 1), a2 + hstep, voffA);
            PG8_WAIT_V(8); PG8_WAIT_L(0); PG8_BAR; PG8_MMA(0, 0, At, B0); PG8_MMA(0, 1, At, B1); PG8_BAR; PG8_SCHED;
            PG8_LDA(At, 1, 1); PG8_STAGE(PG8_SB(1, 0), b3, voffB); PG8_STAGE(PG8_SB(1, 1), b3 + hstep, voffB); PG8_STAGE(PG8_SA(1, 0), a3, voffA);
            PG8_WAIT_V(8); PG8_WAIT_L(0); PG8_BAR; PG8_MMA(1, 0, At, B0); PG8_MMA(1, 1, At, B1); PG8_BAR; PG8_SCHED;
            } else {
            PG8_LDB(B0, 0, 0); PG8_SCHED; PG8_LDA(At, 0, 0); PG8_STAGE(PG8_SA(1, 1), a1 + hstep, voffA);
            PG8_WAIT_L(8); PG8_BAR; PG8_WAIT_L(0); PG8_MMA(0, 0, At, B0); PG8_BAR; PG8_SCHED;
            PG8_LDB(B1, 0, 1); PG8_STAGE(PG8_SB(0, 0), b2, voffB);
            PG8_BAR; PG8_WAIT_L(0); PG8_MMA(0, 1, At, B1); PG8_BAR;
            PG8_LDA(At, 0, 1); PG8_STAGE(PG8_SA(0, 0), a2, voffA);
            PG8_BAR; PG8_WAIT_L(0); PG8_MMA(1, 0, At, B0); PG8_BAR; PG8_SCHED;
            PG8_STAGE(PG8_SB(0, 1), b2 + hstep, voffB);
            PG8_WAIT_V(6); PG8_BAR; PG8_MMA(1, 1, At, B1); PG8_BAR;
            PG8_LDB(B0, 1, 0); PG8_SCHED; PG8_LDA(At, 1, 0); PG8_STAGE(PG8_SA(0, 1), a2 + hstep, voffA);
            PG8_WAIT_L(8); PG8_BAR; PG8_WAIT_L(0); PG8_MMA(0, 0, At, B0); PG8_BAR; PG8_SCHED;
            PG8_LDB(B1, 1, 1); PG8_STAGE(PG8_SB(1, 0), b3, voffB);
            PG8_BAR; PG8_WAIT_L(0); PG8_MMA(0, 1, At, B1); PG8_BAR;
            PG8_LDA(At, 1, 1); PG8_STAGE(PG8_SA(1, 0), a3, voffA);
            PG8_BAR; PG8_WAIT_L(0); PG8_MMA(1, 0, At, B0); PG8_BAR; PG8_SCHED;
            PG8_STAGE(PG8_SB(1, 1), b3 + hstep, voffB);
            PG8_WAIT_V(6); PG8_BAR; PG8_MMA(1, 1, At, B1); PG8_BAR;
            }
        }
        if constexpr (ALIGN_EPI) { if (wr == 0) PG8_BAR; }
        if constexpr (!Epi::AFTER_DRAIN) { E(acc, cur, wr, wc, fr, fq, ui); S.done(cur); }
        if (!has_next) break;
#pragma unroll
        for (int a = 0; a < 2; ++a)
#pragma unroll
            for (int b = 0; b < 2; ++b)
#pragma unroll
                for (int m = 0; m < 4; ++m)
#pragma unroll
                    for (int n = 0; n < 2; ++n) acc[a][b][m][n] = (f32x4){0.f, 0.f, 0.f, 0.f};
        cur = nxt; cA = nA; cB = nB; ++ui;
        if constexpr (ALIGN_EPI) { if (wr == 1) PG8_BAR; }
    }
    PG8_WAIT_V(0);
    if constexpr (!ALIGN_EPI) { if (wr == 0) PG8_BAR; }
    PG8_BAR;
    if constexpr (Epi::AFTER_DRAIN) { E.fused(acc, cur, wr, wc, fr, fq, lds, wid, lane); S.done(cur); }
#undef PG8_SA
#undef PG8_SB
#undef PG8_STAGE
#undef PG8_LDA
#undef PG8_LDB
#undef PG8_MMA
#undef PG8_WAIT_V
#undef PG8_WAIT_L
#undef PG8_BAR
#undef PG8_SCHED
}
}
#define GAS __attribute__((address_space(1)))
#define LAS __attribute__((address_space(3)))
typedef unsigned short bf16;
typedef unsigned v4u __attribute__((ext_vector_type(4)));
typedef float f32x4 __attribute__((ext_vector_type(4)));
typedef short bf16x8 __attribute__((ext_vector_type(8)));
typedef GAS unsigned gu32;
typedef GAS unsigned long long gu64;
#define RLX_AGENT __ATOMIC_RELAXED, __HIP_MEMORY_SCOPE_AGENT
#define LDS_WAIT() asm volatile("s_waitcnt lgkmcnt(0)" ::: "memory")
#define VM_WAIT() asm volatile("s_waitcnt vmcnt(0)" ::: "memory")
__device__ __forceinline__ unsigned long long rt() { return __builtin_amdgcn_s_memrealtime(); }
__device__ __forceinline__ unsigned f2bf(float f) { unsigned u = __builtin_bit_cast(unsigned, f); return (u + 0x7fffu + ((u >> 16) & 1u)) >> 16; }
__device__ __forceinline__ unsigned pk2(float lo, float hi) { return f2bf(lo) | (f2bf(hi) << 16); }

#define XB_TMO      128
#define XB_XCNT(j)  (256  + 64 * (j))
#define XB_XSUB(j)  (1280 + 64 * (j))
#define XB_XGEN(j)  (2304 + 64 * (j))
#define XB_TOP      3328
#define XB_TOPGEN   3392
#define XCD_BAR_WORDS 3456
#define XB_SPIN_CAP (1u << 18)

__device__ __forceinline__ unsigned xb_ld(unsigned* p)              { return __hip_atomic_load(p, __ATOMIC_RELAXED, __HIP_MEMORY_SCOPE_AGENT); }
__device__ __forceinline__ unsigned xb_add(unsigned* p, unsigned v) { return __hip_atomic_fetch_add(p, v, __ATOMIC_RELAXED, __HIP_MEMORY_SCOPE_AGENT); }
__device__ __forceinline__ unsigned xb_xcc_id() { return (unsigned)__builtin_amdgcn_s_getreg((3 << 11) | 20) & 0xFu; }
#define XB_SPIN(cond, bar) do { unsigned _sp = 0; while (cond) { __builtin_amdgcn_s_sleep(1); \
    if ((++_sp & 255u) == 0u) { if (xb_ld(&(bar)[XB_TMO])) break; if (_sp > XB_SPIN_CAP) { atomicAdd(&(bar)[XB_TMO], 1u); break; } } } } while (0)

struct XcdBarrier {
    unsigned* bar; unsigned x;
    volatile LAS unsigned* st;
};

__device__ __forceinline__ XcdBarrier xcd_barrier_post(unsigned* bar, volatile LAS unsigned* st) {
    XcdBarrier b; b.bar = bar; b.x = xb_xcc_id(); b.st = st;
    if (threadIdx.x == 0) (void)xb_add(&bar[XB_XCNT(b.x)], 1u);
    return b;
}
__device__ __forceinline__ void xcd_barrier_complete(unsigned* bar, unsigned x, unsigned& nloc, unsigned& nx) {
    const unsigned G = gridDim.x * gridDim.y * gridDim.z;
    unsigned sum, cnt, mine, sp = 0u;
    for (;;) {
        sum = 0u; cnt = 0u; mine = 0u;
        unsigned cj[16];
#pragma unroll
        for (unsigned j = 0; j < 16; ++j) cj[j] = xb_ld(&bar[XB_XCNT(j)]);
        asm volatile("" : "+v"(cj[0]), "+v"(cj[1]), "+v"(cj[2]), "+v"(cj[3]), "+v"(cj[4]), "+v"(cj[5]), "+v"(cj[6]), "+v"(cj[7]), "+v"(cj[8]), "+v"(cj[9]), "+v"(cj[10]), "+v"(cj[11]), "+v"(cj[12]), "+v"(cj[13]), "+v"(cj[14]), "+v"(cj[15]));
#pragma unroll
        for (unsigned j = 0; j < 16; ++j) { const unsigned c = cj[j]; sum += c; cnt += (c > 0u) ? 1u : 0u; mine = (j == x) ? c : mine; }
        if (sum == G) break;
        __builtin_amdgcn_s_sleep(1);
        if ((++sp & 255u) == 0u) { if (xb_ld(&bar[XB_TMO])) break; if (sp > XB_SPIN_CAP) { atomicAdd(&bar[XB_TMO], 1u); break; } }
    }
    nloc = mine > 0u ? mine : 1u; nx = cnt > 0u ? cnt : 1u;
}

__device__ __forceinline__ void xcd_barrier(const XcdBarrier& b) {
    asm volatile("s_waitcnt vmcnt(0)" ::: "memory");
    __syncthreads();
    if (threadIdx.x == 0) {
        unsigned* bar = b.bar;
        __builtin_amdgcn_s_waitcnt(0);
        unsigned nloc = b.st[0], nx = b.st[1];
        if (nloc == 0u) { xcd_barrier_complete(bar, b.x, nloc, nx); b.st[0] = nloc; b.st[1] = nx; }
        const unsigned old = xb_add(&bar[XB_XSUB(b.x)], 1u);
        const unsigned gen = old / nloc;
        if (old + 1u == (gen + 1u) * nloc) {
            __builtin_amdgcn_fence(__ATOMIC_RELEASE, "agent");
            asm volatile("s_waitcnt vmcnt(0)" ::: "memory");
            const unsigned og = xb_add(&bar[XB_TOP], 1u);
            const unsigned tg = og / nx;
            if (og + 1u == (tg + 1u) * nx) xb_add(&bar[XB_TOPGEN], 1u);
            else XB_SPIN(xb_ld(&bar[XB_TOPGEN]) == tg, bar);
            __builtin_amdgcn_fence(__ATOMIC_ACQUIRE, "agent");
            xb_add(&bar[XB_XGEN(b.x)], 1u);
            asm volatile("s_waitcnt vmcnt(0)" ::: "memory");
        } else {
            XB_SPIN(xb_ld(&bar[XB_XGEN(b.x)]) == gen, bar);
            __builtin_amdgcn_fence(__ATOMIC_ACQUIRE, "agent");
            asm volatile("s_waitcnt vmcnt(0)" ::: "memory");
        }
    }
    __syncthreads();
}

#define DI __device__ __forceinline__
typedef short s16x4 __attribute__((ext_vector_type(4)));
typedef float f32x16 __attribute__((ext_vector_type(16)));
typedef float f32x2 __attribute__((ext_vector_type(2)));
typedef unsigned u32x2 __attribute__((ext_vector_type(2)));
typedef unsigned u32x4 __attribute__((ext_vector_type(4)));
typedef __bf16 bf16x2_t __attribute__((ext_vector_type(2)));

constexpr int DM = 1024, NBATCH = 2, SEQ = 8192, DEPTH = 4, SBATCH = 32, STOK = 8, PAST = 8192;
constexpr int MP = NBATCH * SEQ, MS = SBATCH * STOK, MR = MP + MS;
constexpr int AW = 256, BW = 384, CWD = 384, AH = 4, CH = 6, HD = 64;
constexpr int NG = 24, NP = 64;
constexpr int DFF = 2816, DFF2 = 5632, INW = 2048;
constexpr int O_U = 0, O_V = 256, O_S5 = 512, O_Q = 896, O_K = 1280, O_VV = 1664;
constexpr int CWIN = 2048;
constexpr float EPSN = 1e-6f;
constexpr int NWAVES = 8, NTHR = 512;

constexpr size_t OUT_YP = 0;
constexpr size_t OUT_YS = OUT_YP + (size_t)MP * DM;
constexpr size_t OUT_KP = OUT_YS + (size_t)MS * DM;
constexpr size_t OUT_VP = OUT_KP + (size_t)DEPTH * NBATCH * CWIN * CWD;
constexpr size_t OUT_KS = OUT_VP + (size_t)DEPTH * NBATCH * CWIN * CWD;
constexpr size_t OUT_VS = OUT_KS + (size_t)DEPTH * SBATCH * STOK * CWD;
constexpr size_t OUT_SRP = OUT_VS + (size_t)DEPTH * SBATCH * STOK * CWD;
constexpr size_t OUT_SIP = OUT_SRP + (size_t)DEPTH * NBATCH * NG * NP;
constexpr size_t OUT_SRS = OUT_SIP + (size_t)DEPTH * NBATCH * NG * NP;
constexpr size_t OUT_SIS = OUT_SRS + (size_t)DEPTH * SBATCH * NG * NP;
constexpr size_t OUT_FCP = OUT_SIS + (size_t)DEPTH * SBATCH * NG * NP;
constexpr size_t OUT_FCS = OUT_FCP + (size_t)DEPTH * NBATCH * 2 * DFF2;
constexpr size_t OUT_SGV = OUT_FCS + (size_t)DEPTH * SBATCH * 2 * DFF2;
constexpr size_t OUT_END = OUT_SGV + (size_t)DEPTH * SBATCH * STOK * AW;

constexpr size_t MiB = 1u << 20;
constexpr size_t WS_CTL = 0, CTL_ZERO_BYTES = 1 * MiB;
constexpr size_t WS_ROPE = 1 * MiB;
constexpr size_t WS_S5P = 2 * MiB, S5P_STRIDE = 256 * 1024;
constexpr size_t S5P_BMAT = 0, S5P_CMAT = 98304, S5P_A = 196608;
constexpr size_t WS_WSM = 3 * MiB;
constexpr size_t WS_WGLU = 4 * MiB, WGLU_STRIDE = 384 * 384 * 2;
constexpr size_t WS_S5L = 8 * MiB;
constexpr size_t WS_LSE = 14 * MiB;
constexpr size_t WS_W = 16 * MiB, W_STRIDE = 23592960;
constexpr size_t W_IN = 0, W_OUT = 4 * MiB, W_UP = 6 * MiB, W_DOWN = 17 * MiB;
constexpr size_t WS_X = 106 * MiB;
constexpr size_t WS_XB = 171 * MiB;
constexpr size_t WS_PROJ = 204 * MiB;
constexpr size_t WS_MIX = 269 * MiB;
constexpr size_t WS_OP = 302 * MiB;
constexpr size_t WS_HB = 338 * MiB;
constexpr size_t WS_A2 = 517 * MiB;
constexpr size_t WS_OPS = 607 * MiB;
constexpr size_t WS_LSES = 609 * MiB;
constexpr size_t WS_GSMP = 610 * MiB;
constexpr size_t WS_RSS = 611 * MiB;
constexpr size_t WS_S5PW = 614 * MiB;
constexpr size_t WS_S5SE = 616 * MiB;
constexpr size_t WS_END = 617 * MiB;
static_assert(W_STRIDE == 4 * MiB + 2 * MiB + 11 * MiB + 5 * MiB + MiB / 2, "weights");
static_assert(WS_W + 4 * W_STRIDE <= WS_X && WS_X + (size_t)MR * DM * 4 <= WS_XB && WS_XB + (size_t)MR * DM * 2 <= WS_PROJ && WS_PROJ + (size_t)MR * INW * 2 <= WS_MIX &&
              WS_MIX + (size_t)MR * DM * 2 <= WS_OP && WS_OP + (size_t)3 * MP * CWD * 2 <= WS_HB && WS_HB + (size_t)MR * DFF2 * 2 <= WS_A2 && WS_A2 + (size_t)MR * DFF * 2 <= WS_OPS, "ws map");
static_assert(WS_S5L + (size_t)64 * 4 * 2 * 24 * 64 * 8 <= WS_LSE && WS_LSE + (size_t)3 * MP * 6 * 4 <= WS_W, "ws map 2");

constexpr int CW_Q = 16384;
constexpr int CW_BAR = 4096;

constexpr int RING_BYTES = 131072, LDSCTL_OFF = RING_BYTES, MISC_OFF = LDSCTL_OFF + 320, RSTD_OFF = LDSCTL_OFF + 1024  , LDS_BYTES = 147456;

DI float bf2f(unsigned short v) { return __uint_as_float(((unsigned)v) << 16); }
DI unsigned cvtpk(float lo, float hi) { f32x2 v = {lo, hi}; bf16x2_t b = __builtin_convertvector(v, bf16x2_t); return __builtin_bit_cast(unsigned, b); }
DI unsigned short f2bf1(float x) { return (unsigned short)(cvtpk(x, 0.f) & 0xffffu); }
DI float gelu_t(float x) {
    const float t = x * x, u = t * -0.1029432397f - 2.3022081985f;
    return x * __builtin_amdgcn_rcpf(1.0f + __builtin_amdgcn_exp2f(x * u));
}
DI float sigmoid_f(float x) { return __builtin_amdgcn_rcpf(1.0f + __builtin_amdgcn_exp2f(-1.4426950409f * x)); }
DI int crow(int reg, int h) { return (reg & 3) + 8 * (reg >> 2) + 4 * h; }
DI f32x16 mfma32(bf16x8 a, bf16x8 b, f32x16 c) { return __builtin_amdgcn_mfma_f32_32x32x16_bf16(a, b, c, 0, 0, 0); }
DI f32x16 zero16() { f32x16 z; for (int i = 0; i < 16; ++i) z[i] = 0.f; return z; }
DI float wave_sum(float v) {
    v += __builtin_bit_cast(float, __builtin_amdgcn_update_dpp(0, __builtin_bit_cast(int, v), 0x128, 0xf, 0xf, false));
    v += __builtin_bit_cast(float, __builtin_amdgcn_update_dpp(0, __builtin_bit_cast(int, v), 0x124, 0xf, 0xf, false));
    v += __builtin_bit_cast(float, __builtin_amdgcn_update_dpp(0, __builtin_bit_cast(int, v), 0x122, 0xf, 0xf, false));
    v += __builtin_bit_cast(float, __builtin_amdgcn_update_dpp(0, __builtin_bit_cast(int, v), 0x121, 0xf, 0xf, false));
    v += __shfl_xor(v, 16); v += __shfl_xor(v, 32);
    return v;
}
DI float wave_max(float v) {
#pragma unroll
    for (int o = 1; o < 64; o <<= 1) v = fmaxf(v, __shfl_xor(v, o));
    return v;
}
DI int rope_phys(int d) { return d < 8 ? 2 * d : (d < 16 ? 2 * (d - 8) + 1 : d); }
__host__ __device__ inline int rope_log(int p) { return p < 16 ? ((p & 1) ? 8 + (p >> 1) : (p >> 1)) : p; }
DI int row_pos(int row) { return row < MP ? (row & (SEQ - 1)) : PAST + ((row - MP) & (STOK - 1)); }

struct Args { const float* in[28]; float* out; unsigned char* ws; int ph_lo, ph_hi; };
struct Frame {
    LAS unsigned char* lds;
    int tid, lane, wave, G, bid;
    float* out;
    unsigned char* ws;
};
#define FIN(k) (args.in[k])
DI void launder(Frame& F) { asm volatile("" : "+s"(F.bid), "+s"(F.G)); int ln = (int)__builtin_amdgcn_mbcnt_hi(~0u, __builtin_amdgcn_mbcnt_lo(~0u, 0u)); asm volatile("" : "+v"(ln)); F.lane = ln; F.tid = F.wave * 64 + ln; }
DI int launder_i(int x) { asm volatile("" : "+s"(x)); return x; }

DI float row_rstd(const float* rss, int row) {
    const f32x4* rp = (const f32x4*)(rss + (size_t)row * 32);
    float s = 0.f;
#pragma unroll
    for (int i = 0; i < 8; ++i) { const f32x4 a = rp[i]; s += (a.x + a.y) + (a.z + a.w); }
    return 1.0f / sqrtf(s * (1.0f / DM) + EPSN);
}
DI void store8_bf16(bf16* dst, const float (&v)[8]) {
    u32x4 w; w.x = cvtpk(v[0], v[1]); w.y = cvtpk(v[2], v[3]); w.z = cvtpk(v[4], v[5]); w.w = cvtpk(v[6], v[7]);
    *(u32x4*)dst = w;
}

template <class Sched> DI void build_rstd_table(Frame& F, const Sched& S, const float* rss) {
    LAS float* tab = (LAS float*)(F.lds + RSTD_OFF);
    pg8::Unit u;
    for (int i = 0; i < 6 && S.next(i, u); ++i) if (F.tid < 256) tab[i * 256 + F.tid] = row_rstd(rss, u.pm * 256 + F.tid);
    __syncthreads();
}

DI void epi_in_apply(int row, int c0, float (&v)[8], const f32x4 t0, const f32x4 t1, bf16* proj, float* out, int layer) {
    const int hd = (c0 - O_Q) & 63;
    if (c0 < O_S5) {
#pragma unroll
        for (int e = 0; e < 8; ++e) v[e] = gelu_t(v[e]);
    } else if (c0 >= O_Q) {
        const int head = ((c0 - O_Q) >> 6) % CH;
        const bool isk = c0 >= O_K && c0 < O_VV, isv = c0 >= O_VV;
        if (!isv && hd < 16) {
            const float cs[4] = {t0.x, t0.z, t1.x, t1.z}, sn[4] = {t0.y, t0.w, t1.y, t1.w};
#pragma unroll
            for (int j = 0; j < 4; ++j) { const float x1 = v[2 * j], x2 = v[2 * j + 1]; v[2 * j] = x1 * cs[j] - x2 * sn[j]; v[2 * j + 1] = x2 * cs[j] + x1 * sn[j]; }
        }
        if (isk || isv) {
            float* dst = nullptr;
            if (row < MP) { const int b = row >> 13, t = row & (SEQ - 1);
                if (t >= SEQ - CWIN) dst = out + (isk ? OUT_KP : OUT_VP) + ((((size_t)layer * NBATCH + b) * CWIN + (t - (SEQ - CWIN))) * CH + head) * HD;
            } else { const int rs_ = row - MP;
                dst = out + (isk ? OUT_KS : OUT_VS) + (((size_t)layer * MS + rs_) * CH + head) * HD; }
            if (dst) {
                if (isk && hd < 16) { *(f32x4*)(dst + (hd >> 1)) = (f32x4){v[0], v[2], v[4], v[6]}; *(f32x4*)(dst + 8 + (hd >> 1)) = (f32x4){v[1], v[3], v[5], v[7]}; }
                else { *(f32x4*)(dst + hd) = (f32x4){v[0], v[1], v[2], v[3]}; *(f32x4*)(dst + hd + 4) = (f32x4){v[4], v[5], v[6], v[7]}; }
            }
        }
    }
    store8_bf16(proj + (size_t)row * INW + c0, v);
}

struct EpiIn {
    static constexpr bool PERM = true, AFTER_DRAIN = false, APERM = false;
    bf16* proj; const LAS float* tab; const f32x2* rope; float* out; int layer;
    DI void operator()(const pg8::f32x4 (&acc)[2][2][4][2], const pg8::Unit& u, int wr, int wc, int fr, int fq, int ui) const {
        const int hd = (32 * wc + 8 * fq) & 63;
        const int cA = u.pn * 256 + wc * 32 + 8 * fq;
        const bool ropeA = cA >= O_Q && cA < O_VV && hd < 16, ropeB = cA + 128 >= O_Q && cA + 128 < O_VV && hd < 16;
#pragma unroll
        for (int ai = 0; ai < 2; ++ai) {
            float rs[4]; f32x4 t0[4], t1[4];
#pragma unroll
            for (int m = 0; m < 4; ++m) { rs[m] = tab[ui * 256 + ai * 128 + wr * 64 + m * 16 + fr]; t0[m] = (f32x4){1.f, 0.f, 1.f, 0.f}; t1[m] = t0[m]; }
            if (ropeA || ropeB) {
#pragma unroll
                for (int m = 0; m < 4; ++m) { const int row = u.pm * 256 + ai * 128 + wr * 64 + m * 16 + fr; const f32x4* rp = (const f32x4*)(rope + (size_t)row_pos(row) * 8 + (hd >> 1)); t0[m] = rp[0]; t1[m] = rp[1]; }
            }
#pragma unroll
            for (int m = 0; m < 4; ++m) {
                const int row = u.pm * 256 + ai * 128 + wr * 64 + m * 16 + fr;
#pragma unroll
                for (int bj = 0; bj < 2; ++bj) {
                    float v[8];
#pragma unroll
                    for (int e = 0; e < 4; ++e) { v[e] = acc[ai][bj][m][0][e] * rs[m]; v[4 + e] = acc[ai][bj][m][1][e] * rs[m]; }
                    epi_in_apply(row, cA + bj * 128, v, t0[m], t1[m], proj, out, layer);
                }
            }
            asm volatile("" ::: "memory");
        }
    }
};

struct EpiRes {
    static constexpr bool PERM = true, AFTER_DRAIN = false, APERM = false;
    const float* xp; const float* xs; float* X; bf16* XB; float* rss; int first; int dry; int wf32;
    DI void operator()(const pg8::f32x4 (&acc)[2][2][4][2], const pg8::Unit& u, int wr, int wc, int fr, int fq, int ui) const {
#pragma unroll
        for (int ai = 0; ai < 2; ++ai) {
            f32x4 xo[4][2][2];
            if (first) {
#pragma unroll
                for (int m = 0; m < 4; ++m) {
                    const int row = u.pm * 256 + ai * 128 + wr * 64 + m * 16 + fr;
                    const float* src = row < MP ? xp + (size_t)row * DM : xs + (size_t)(row - MP) * DM;
#pragma unroll
                    for (int bj = 0; bj < 2; ++bj) { const int c0 = u.pn * 256 + bj * 128 + wc * 32 + 8 * fq; xo[m][bj][0] = *(const f32x4*)(src + c0); xo[m][bj][1] = *(const f32x4*)(src + c0 + 4); }
                }
            } else {
#pragma unroll
                for (int m = 0; m < 4; ++m) {
                    const int row = u.pm * 256 + ai * 128 + wr * 64 + m * 16 + fr;
#pragma unroll
                    for (int bj = 0; bj < 2; ++bj) { const int c0 = u.pn * 256 + bj * 128 + wc * 32 + 8 * fq; const u32x4 rw = *(const u32x4*)(XB + (size_t)row * DM + c0);
                        xo[m][bj][0] = (f32x4){__uint_as_float(rw.x << 16), __uint_as_float(rw.x & 0xffff0000u), __uint_as_float(rw.y << 16), __uint_as_float(rw.y & 0xffff0000u)};
                        xo[m][bj][1] = (f32x4){__uint_as_float(rw.z << 16), __uint_as_float(rw.z & 0xffff0000u), __uint_as_float(rw.w << 16), __uint_as_float(rw.w & 0xffff0000u)}; }
                }
            }
#pragma unroll
            for (int m = 0; m < 4; ++m) {
                const int row = u.pm * 256 + ai * 128 + wr * 64 + m * 16 + fr;
                float ss = 0.f;
#pragma unroll
                for (int bj = 0; bj < 2; ++bj) {
                    const int c0 = u.pn * 256 + bj * 128 + wc * 32 + 8 * fq;
                    float v[8];
#pragma unroll
                    for (int e = 0; e < 4; ++e) { v[e] = acc[ai][bj][m][0][e] + xo[m][bj][0][e]; v[4 + e] = acc[ai][bj][m][1][e] + xo[m][bj][1][e]; }
                    if (!dry) { store8_bf16(XB + (size_t)row * DM + c0, v);
                        if (wf32) { *(f32x4*)(X + (size_t)row * DM + c0) = (f32x4){v[0], v[1], v[2], v[3]}; *(f32x4*)(X + (size_t)row * DM + c0 + 4) = (f32x4){v[4], v[5], v[6], v[7]}; } }
#pragma unroll
                    for (int e = 0; e < 8; ++e) ss += v[e] * v[e];
                }
                ss += __shfl_xor(ss, 16); ss += __shfl_xor(ss, 32);
                if (fq == 0 && !dry) rss[(size_t)row * 32 + u.pn * 4 + wc] = ss;
            }
            asm volatile("" ::: "memory");
        }
    }
};

constexpr int UP_PANELS = 66, UP_PPB = 33, UP_STEP = 254, UP_SMP = 9999;
struct UpOrder : pg8::StaticOrder {
    DI long a_off(const pg8::Unit& u, long tstep) const { const int b = u.pm / UP_PPB, p = u.pm % UP_PPB; return ((long)(u.pm == UP_SMP ? MP : b * SEQ + UP_STEP * p - 2) * (tstep >> 8)); }
};
constexpr int PAR_OFF = RSTD_OFF + 6144 + 8192;
template <class Sched> DI void build_rstd_table_up(Frame& F, const Sched& S, const float* rss, const float* cw, const float* cb) {
    LAS float* tab = (LAS float*)(F.lds + RSTD_OFF);
    pg8::Unit u;
    for (int i = 0; i < 6 && S.next(i, u); ++i) {
        if (F.tid < 256) { const int b = u.pm / UP_PPB, p = u.pm % UP_PPB, row = (u.pm == UP_SMP ? MP : b * SEQ + UP_STEP * p - 2) + F.tid; tab[i * 256 + F.tid] = (row >= 0) ? row_rstd(rss, row) : 1.0f; }
    }
    if (F.bid >= F.G - 22 && F.bid >= (UP_PANELS * 22) % F.G && (UP_PANELS * 22) % F.G > 0 && F.tid < 256) tab[5 * 256 + F.tid] = row_rstd(rss, MP + F.tid);
    __syncthreads();
}
DI float dpp_ror1(float x) { return __builtin_bit_cast(float, __builtin_amdgcn_mov_dpp(__builtin_bit_cast(int, x), 0x121, 0xf, 0xf, true)); }
DI float dpp_ror2(float x) { return __builtin_bit_cast(float, __builtin_amdgcn_mov_dpp(__builtin_bit_cast(int, x), 0x122, 0xf, 0xf, true)); }
DI float dpp_shr1_old(float old, float x) { return __builtin_bit_cast(float, __builtin_amdgcn_update_dpp(__builtin_bit_cast(int, old), __builtin_bit_cast(int, x), 0x111, 0xf, 0xf, false)); }
DI float dpp_shr2_old(float old, float x) { return __builtin_bit_cast(float, __builtin_amdgcn_update_dpp(__builtin_bit_cast(int, old), __builtin_bit_cast(int, x), 0x112, 0xf, 0xf, false)); }
DI float gelu_mul(float x, float y) {
    const float t = x * x, u = t * -0.1029432397f - 2.3022081985f, z = x * u;
    return (x * __builtin_amdgcn_rcpf(1.0f + __builtin_amdgcn_exp2f(z))) * y;
}
constexpr int XCH_OFF = RSTD_OFF + 6144;
struct EpiNull { static constexpr bool PERM = true, AFTER_DRAIN = false, APERM = false; float* sink;
    DI void operator()(pg8::f32x4 (&acc)[2][2][4][2], const pg8::Unit& u, int wr, int wc, int fr, int fq, int ui) const { float s = 0.f;
#pragma unroll
        for (int a = 0; a < 2; ++a)
#pragma unroll
            for (int b = 0; b < 2; ++b)
#pragma unroll
                for (int m = 0; m < 4; ++m)
#pragma unroll
                    for (int n = 0; n < 2; ++n) s += (acc[a][b][m][n][0] + acc[a][b][m][n][1]) + (acc[a][b][m][n][2] + acc[a][b][m][n][3]);
        if (s == 1.2345e-30f) sink[0] = 1.f; } };
constexpr int SMP_UNITS = 22;
struct SmpOrder {
    int G, c;
    DI bool next(int i, pg8::Unit& u) const { const int k = c - (G - SMP_UNITS); if (i != 0 || k < 0) return false; u.pm = 0; u.pn = k; return true; }
    DI long a_off(const pg8::Unit&, long tstep) const { return (long)MP * (tstep >> 8); }
    DI void a_ready(const pg8::Unit&) const {}
    DI void done(const pg8::Unit&) const {}
};
struct EpiUpSample {
    static constexpr bool PERM = true, AFTER_DRAIN = true, APERM = false;
    bf16* a2; LAS float* rst; const float* rss; const float* cw; const float* cb; const float* sbuf; float* out; int layer; int pre;
    DI void fused(pg8::f32x4 (&acc)[2][2][4][2], const pg8::Unit& u, int wr, int wc, int fr, int fq, PG8_LAS unsigned char* lds, int wid, int lane) const {
        const int tid = wid * 64 + lane;
        if (!pre) { if (tid < 256) rst[tid] = row_rstd(rss, MP + tid);
            asm volatile("s_waitcnt vmcnt(0) lgkmcnt(0)" ::: "memory"); __builtin_amdgcn_s_barrier(); asm volatile("" ::: "memory"); }
        const int jg = u.pn * 128 + wc * 32 + 8 * fq;
#pragma unroll
        for (int ai = 0; ai < 2; ++ai)
#pragma unroll
            for (int m = 0; m < 4; ++m) { const int r = ai * 128 + wr * 64 + m * 16 + fr, t = r & 7, sb = r >> 3; const float rs = rst[r];
#pragma unroll
                for (int bj = 0; bj < 2; ++bj) { const pg8::f32x4 v0 = acc[ai][bj][m][0] * rs, v1 = acc[ai][bj][m][1] * rs;
                    if (t >= STOK - 2) { float* sd = out + OUT_FCS + (((size_t)layer * SBATCH + sb) * 2 + (t - (STOK - 2))) * DFF2 + bj * DFF + jg; *(pg8::f32x4*)sd = v0; *(pg8::f32x4*)(sd + 4) = v1; }
                    u32x4 w; w.x = cvtpk(v0[0], v0[1]); w.y = cvtpk(v0[2], v0[3]); w.z = cvtpk(v1[0], v1[1]); w.w = cvtpk(v1[2], v1[3]);
                    const int c = bj * 16 + wc * 4 + fq; *(PG8_LAS u32x4*)(lds + (size_t)(r * 32 + (c ^ (r & 15))) * 16) = w; } }
        asm volatile("s_waitcnt lgkmcnt(0)" ::: "memory"); __builtin_amdgcn_s_barrier(); asm volatile("" ::: "memory");
        { const int cc = tid & 15, t = (tid >> 4) & 7, j0 = u.pn * 128 + 8 * cc;
          float cbv[2][8], cwv[3][2][8];
#pragma unroll
          for (int half = 0; half < 2; ++half) { const int col = half * DFF + j0;
              { const f32x4 b0 = *(const f32x4*)(cb + col), b1 = *(const f32x4*)(cb + col + 4); cbv[half][0] = b0.x; cbv[half][1] = b0.y; cbv[half][2] = b0.z; cbv[half][3] = b0.w; cbv[half][4] = b1.x; cbv[half][5] = b1.y; cbv[half][6] = b1.z; cbv[half][7] = b1.w; }
#pragma unroll
              for (int tap = 0; tap < 3; ++tap) { const f32x4 w0 = *(const f32x4*)(cw + (size_t)tap * DFF2 + col), w1 = *(const f32x4*)(cw + (size_t)tap * DFF2 + col + 4);
                  cwv[tap][half][0] = w0.x; cwv[tap][half][1] = w0.y; cwv[tap][half][2] = w0.z; cwv[tap][half][3] = w0.w; cwv[tap][half][4] = w1.x; cwv[tap][half][5] = w1.y; cwv[tap][half][6] = w1.z; cwv[tap][half][7] = w1.w; } }
#pragma unroll 2
          for (int q = 0; q < 8; ++q) { const int row = (tid >> 4) + 32 * q, sb = row >> 3;
            float hc[2][8];
#pragma unroll
            for (int half = 0; half < 2; ++half) { const int col = half * DFF + j0;
#pragma unroll
                for (int e2 = 0; e2 < 8; ++e2) hc[half][e2] = cbv[half][e2];
#pragma unroll
                for (int tap = 0; tap < 3; ++tap) { const int back = 2 - tap; float hv[8];
                    if (t - back >= 0) { const int rr = row - back, c = half * 16 + cc; const u32x4 rw = *(const PG8_LAS u32x4*)(lds + (size_t)(rr * 32 + (c ^ (rr & 15))) * 16);
#pragma unroll
                        for (int e2 = 0; e2 < 4; ++e2) { hv[2 * e2] = __uint_as_float(rw[e2] << 16); hv[2 * e2 + 1] = __uint_as_float(rw[e2] & 0xffff0000u); } }
                    else { const float* sp = sbuf + (((size_t)layer * SBATCH + sb) * 2 + (t - back + 2)) * DFF2 + col; const f32x4 s0 = *(const f32x4*)sp, s1 = *(const f32x4*)(sp + 4);
                        hv[0] = s0.x; hv[1] = s0.y; hv[2] = s0.z; hv[3] = s0.w; hv[4] = s1.x; hv[5] = s1.y; hv[6] = s1.z; hv[7] = s1.w; }
#pragma unroll
                    for (int e2 = 0; e2 < 8; ++e2) hc[half][e2] += cwv[tap][half][e2] * hv[e2]; } }
            float o[8];
#pragma unroll
            for (int e2 = 0; e2 < 8; ++e2) o[e2] = gelu_t(hc[0][e2]) * hc[1][e2];
            store8_bf16(a2 + (size_t)(MP + row) * DFF + j0, o); } }
    }
};
struct EpiStoreOnly { static constexpr bool PERM = true, AFTER_DRAIN = false, APERM = false; bf16* a2;
    DI void operator()(pg8::f32x4 (&acc)[2][2][4][2], const pg8::Unit& u, int wr, int wc, int fr, int fq, int ui) const {
        const int b = u.pm / UP_PPB, p = u.pm % UP_PPB, tbase = UP_STEP * p - 2, jg = u.pn * 128 + wc * 32 + 8 * fq;
#pragma unroll
        for (int ai = 0; ai < 2; ++ai)
#pragma unroll
            for (int m = 0; m < 4; ++m) { const int r = ai * 128 + wr * 64 + m * 16 + fr, t = tbase + r;
                if (r >= 2 && t < SEQ) { float v[8];
#pragma unroll
                    for (int e = 0; e < 4; ++e) { v[e] = acc[ai][0][m][0][e] + acc[ai][1][m][0][e]; v[4 + e] = acc[ai][0][m][1][e] + acc[ai][1][m][1][e]; }
                    store8_bf16(a2 + (size_t)(b * SEQ + t) * DFF + jg, v); } } } };
struct EpiUpConv {
    static constexpr bool PERM = true, AFTER_DRAIN = false, APERM = true;
    bf16* a2; const LAS float* tab; LAS float* xch; const float* cw; const float* cb; const float* sbuf; float* out; int layer; int mode;
    DI void operator()(pg8::f32x4 (&acc)[2][2][4][2], const pg8::Unit& u, int wr, int wc, int fr, int fq, int ui) const {
        const int b = u.pm / UP_PPB, p = u.pm % UP_PPB, tbase = UP_STEP * p - 2;
        float rs[2][4];
#pragma unroll
        for (int ai = 0; ai < 2; ++ai) { const pg8::f32x4 r4 = *(const LAS pg8::f32x4*)(tab + ui * 256 + ai * 128 + wr * 64 + 4 * fr); rs[ai][0] = r4[0]; rs[ai][1] = r4[1]; rs[ai][2] = r4[2]; rs[ai][3] = r4[3]; }
        const bool z00 = (p == 0 && wr == 0 && fr == 0);
        if (fr == 15) {
#pragma unroll
            for (int ai = 0; ai < 2; ++ai)
#pragma unroll
                for (int bj = 0; bj < 2; ++bj)
#pragma unroll
                    for (int n = 0; n < 2; ++n)
#pragma unroll
                        for (int mm = 0; mm < 2; ++mm) { pg8::f32x4 v = acc[ai][bj][2 + mm][n] * rs[ai][2 + mm];
                            *(LAS pg8::f32x4*)(xch + ((((ai * 2 + wr) * 2 + mm) * 4 + wc) * 64 + bj * 32 + 8 * fq + 4 * n)) = v; }
        }
        asm volatile("s_waitcnt lgkmcnt(0)" ::: "memory"); __builtin_amdgcn_s_barrier(); asm volatile("" ::: "memory");
        const int jg = u.pn * 128 + wc * 32 + 8 * fq;
        if (p == UP_PPB - 1) {
#pragma unroll
            for (int ai = 0; ai < 2; ++ai)
#pragma unroll
                for (int m = 0; m < 4; ++m) { const int t = tbase + ai * 128 + wr * 64 + 4 * fr + m;
                    if (t == SEQ - 2 || t == SEQ - 1) { float* sd = out + OUT_FCP + (((size_t)layer * NBATCH + b) * 2 + (t - (SEQ - 2))) * DFF2 + jg;
#pragma unroll
                        for (int bj = 0; bj < 2; ++bj)
#pragma unroll
                            for (int n = 0; n < 2; ++n) *(pg8::f32x4*)(sd + bj * DFF + 4 * n) = acc[ai][bj][m][n] * rs[ai][m]; } }
        }
#pragma unroll
        for (int n = 0; n < 2; ++n) {
            asm volatile("" ::: "memory");
            const int j4 = jg + 4 * n;
            const pg8::f32x4 cbg = *(const pg8::f32x4*)(cb + j4), cbu = *(const pg8::f32x4*)(cb + DFF + j4);
            const pg8::f32x4 w0g = *(const pg8::f32x4*)(cw + j4), w0u = *(const pg8::f32x4*)(cw + DFF + j4);
            const pg8::f32x4 w1g = *(const pg8::f32x4*)(cw + DFF2 + j4), w1u = *(const pg8::f32x4*)(cw + DFF2 + DFF + j4);
            const pg8::f32x4 w2g = *(const pg8::f32x4*)(cw + 2 * DFF2 + j4), w2u = *(const pg8::f32x4*)(cw + 2 * DFF2 + DFF + j4);
#pragma unroll
            for (int ep = 0; ep < 2; ++ep) {
                const f32x2 cbg2 = {cbg[2 * ep], cbg[2 * ep + 1]}, cbu2 = {cbu[2 * ep], cbu[2 * ep + 1]};
                const f32x2 w0g2 = {w0g[2 * ep], w0g[2 * ep + 1]}, w0u2 = {w0u[2 * ep], w0u[2 * ep + 1]}, w1g2 = {w1g[2 * ep], w1g[2 * ep + 1]}, w1u2 = {w1u[2 * ep], w1u[2 * ep + 1]};
                const f32x2 w2g2 = {w2g[2 * ep], w2g[2 * ep + 1]}, w2u2 = {w2u[2 * ep], w2u[2 * ep + 1]};
#pragma unroll
                for (int ai = 0; ai < 2; ++ai) {
                    asm volatile("" ::: "memory");
                    f32x2 x0g, x1g, x0u, x1u;
                    { const int pa = (ai + wr == 2) ? 1 : 0, pw = (ai == 1 && wr == 0) ? 1 : 0;
                        const LAS float* xb = xch + (((pa * 2 + pw) * 2) * 4 + wc) * 64 + 8 * fq + 4 * n + 2 * ep;
                        x0g = *(const LAS f32x2*)(xb); x0u = *(const LAS f32x2*)(xb + 32); x1g = *(const LAS f32x2*)(xb + 256); x1u = *(const LAS f32x2*)(xb + 256 + 32); }
                    f32x2 hg[4], hu[4];
#pragma unroll
                    for (int m = 0; m < 4; ++m) { hg[m] = (f32x2){acc[ai][0][m][n][2 * ep], acc[ai][0][m][n][2 * ep + 1]} * rs[ai][m]; hu[m] = (f32x2){acc[ai][1][m][n][2 * ep], acc[ai][1][m][n][2 * ep + 1]} * rs[ai][m]; }
                    if (ai == 0 && z00) { hg[0] = (f32x2){0.f, 0.f}; hu[0] = (f32x2){0.f, 0.f}; hg[1] = (f32x2){0.f, 0.f}; hu[1] = (f32x2){0.f, 0.f}; }
#pragma unroll
                    for (int m = 0; m < 4; ++m) asm volatile("" : "+v"(hg[m].x), "+v"(hg[m].y), "+v"(hu[m].x), "+v"(hu[m].y));
                    const f32x2 s3g = {dpp_shr1_old(x1g.x, hg[3].x), dpp_shr1_old(x1g.y, hg[3].y)}, s2g = {dpp_shr1_old(x0g.x, hg[2].x), dpp_shr1_old(x0g.y, hg[2].y)};
                    const f32x2 s3u = {dpp_shr1_old(x1u.x, hu[3].x), dpp_shr1_old(x1u.y, hu[3].y)}, s2u = {dpp_shr1_old(x0u.x, hu[2].x), dpp_shr1_old(x0u.y, hu[2].y)};
                    f32x2 ares[4];
#pragma unroll
                    for (int m = 0; m < 4; ++m) {
                        const f32x2 h1g = m == 0 ? s3g : hg[m - 1], h2g = m == 0 ? s2g : (m == 1 ? s3g : hg[m - 2]);
                        const f32x2 h1u = m == 0 ? s3u : hu[m - 1], h2u = m == 0 ? s2u : (m == 1 ? s3u : hu[m - 2]);
                        const f32x2 hcg = cbg2 + w0g2 * h2g + w1g2 * h1g + w2g2 * hg[m], hcu = cbu2 + w0u2 * h2u + w1u2 * h1u + w2u2 * hu[m];
                        const f32x2 t = hcg * hcg, uq = t * -0.1029432397f - 2.3022081985f, z = hcg * uq;
                        f32x2 ex; ex.x = __builtin_amdgcn_exp2f(z.x); ex.y = __builtin_amdgcn_exp2f(z.y);
                        const f32x2 dn = ex + 1.0f; f32x2 rc; rc.x = __builtin_amdgcn_rcpf(dn.x); rc.y = __builtin_amdgcn_rcpf(dn.y);
                        ares[m] = (hcg * rc) * hcu;
                    }
#pragma unroll
                    for (int m = 0; m < 4; ++m) asm volatile("" : "+v"(ares[m].x), "+v"(ares[m].y));
#pragma unroll
                    for (int m = 0; m < 4; ++m) { acc[ai][0][m][n][2 * ep] = ares[m].x; acc[ai][0][m][n][2 * ep + 1] = ares[m].y; }
                }
            }
        }
#pragma unroll
        for (int ai = 0; ai < 2; ++ai)
#pragma unroll
            for (int m = 0; m < 4; ++m) { const int r = ai * 128 + wr * 64 + 4 * fr + m, t = tbase + r;
                if (r >= 2 && t < SEQ && (mode == 0 || acc[ai][0][m][0][0] == 1.2345e-30f)) { float v[8];
#pragma unroll
                    for (int e = 0; e < 4; ++e) { v[e] = acc[ai][0][m][0][e]; v[4 + e] = acc[ai][0][m][1][e]; }
                    store8_bf16(a2 + (size_t)(b * SEQ + t) * DFF + jg, v); } }
    }
};

template <int MODE> DI int wrow_map(int n) {
    if (MODE == 1) { if (n >= O_Q && n < O_VV) { const int dl = (n - O_Q) & 63; return n - dl + rope_phys(dl); } return n; }
    if (MODE == 2) { const int bj = n >= DFF ? 1 : 0, j = n - bj * DFF; return 256 * (j >> 7) + 128 * bj + (j & 127); }
    return n;
}
template <int MODE, bool GAIN> DI void transpose_item(const float* W, int K, int N, bf16* WT, LAS float* scr, int item, int lane, const float* gain) {
    const int nblk = N / 32, kb = item / nblk, nb = item % nblk, k0 = 64 * kb, n0 = 32 * nb;
    float wv[32];
#pragma unroll
    for (int i = 0; i < 32; ++i) { const int kk = 2 * i + (lane >> 5); wv[i] = W[(size_t)(k0 + kk) * N + n0 + (lane & 31)]; }
    const int c = lane & 7;
    f32x4 g0 = (f32x4){1.f, 1.f, 1.f, 1.f}, g1 = g0;
    if (GAIN) { g0 = *(const f32x4*)(gain + k0 + 8 * c); g1 = *(const f32x4*)(gain + k0 + 8 * c + 4); }
#pragma unroll
    for (int i = 0; i < 32; ++i) { const int kk = 2 * i + (lane >> 5); scr[kk * 33 + (lane & 31)] = wv[i]; }
    LDS_WAIT(); asm volatile("" ::: "memory");
#pragma unroll
    for (int j = 0; j < 4; ++j) { const int n = (lane >> 3) + 8 * j; const LAS float* s = scr + (8 * c) * 33 + n;
        u32x4 o; o.x = cvtpk(s[0 * 33] * g0.x, s[1 * 33] * g0.y); o.y = cvtpk(s[2 * 33] * g0.z, s[3 * 33] * g0.w); o.z = cvtpk(s[4 * 33] * g1.x, s[5 * 33] * g1.y); o.w = cvtpk(s[6 * 33] * g1.z, s[7 * 33] * g1.w);
        *(u32x4*)(WT + (size_t)wrow_map<MODE>(n0 + n) * K + k0 + 8 * c) = o; }
    LDS_WAIT(); asm volatile("" ::: "memory");
}

DI void convert_layer_weights(const Args& args, Frame& F, int l, int first_block, int nblocks) {
    launder(F);
    LAS float* scr = (LAS float*)(F.lds + F.wave * 16384);
    const int gw = (F.bid - first_block) * NWAVES + F.wave, NGW = nblocks * NWAVES;
    constexpr int I_IN = (DM / 64) * (INW / 32), I_OUT = (DM / 64) * (DM / 32), I_UP = (DM / 64) * (DFF2 / 32), I_DN = (DFF / 64) * (DM / 32), I_GL = (BW / 64) * (BW / 32);
    constexpr int I_L = I_IN + I_OUT + I_UP + I_DN + I_GL;
    bf16* wl = (bf16*)(F.ws + WS_W + (size_t)l * W_STRIDE);
    for (int it = gw; it < I_L; it += NGW) {
        int r = it;
        if (r < I_IN) { transpose_item<1, true>(args.in[8] + (size_t)l * DM * INW, DM, INW, (bf16*)((unsigned char*)wl + W_IN), scr, r, F.lane, args.in[7] + l * DM); continue; } r -= I_IN;
        if (r < I_OUT) { transpose_item<0, false>(args.in[21] + (size_t)l * DM * DM, DM, DM, (bf16*)((unsigned char*)wl + W_OUT), scr, r, F.lane, nullptr); continue; } r -= I_OUT;
        if (r < I_UP) { transpose_item<2, true>(args.in[23] + (size_t)l * DM * DFF2, DM, DFF2, (bf16*)((unsigned char*)wl + W_UP), scr, r, F.lane, args.in[22] + l * DM); continue; } r -= I_UP;
        if (r < I_DN) { transpose_item<0, false>(args.in[26] + (size_t)l * DFF * DM, DFF, DM, (bf16*)((unsigned char*)wl + W_DOWN), scr, r, F.lane, nullptr); continue; } r -= I_DN;
        transpose_item<0, false>(args.in[19] + (size_t)l * BW * BW, BW, BW, (bf16*)(F.ws + WS_WGLU + (size_t)l * WGLU_STRIDE), scr, r, F.lane, nullptr);
    }
}

DI void prologue(const Args& args, Frame& F) {
    launder(F);
    LAS float* scr = (LAS float*)(F.lds + F.wave * 16384);
    const int gw = F.bid * NWAVES + F.wave, NGW = F.G * NWAVES;
    const int gt = F.bid * NTHR + F.tid, NGT = F.G * NTHR;
    convert_layer_weights(args, F, 0, 0, F.G);
    { bf16* wsm = (bf16*)(F.ws + WS_WSM); const float* ws_ = args.in[9];
      for (int i = gt; i < DEPTH * AH * 128 * 128; i += NGT) { const int jj = i & 127, ii = (i >> 7) & 127; wsm[i] = (jj <= ii) ? f2bf1(ws_[i]) : (unsigned short)0; } }
    for (int i = gt; i < DEPTH * NG * NP; i += NGT) {
        const int l = i / (NG * NP), gp = i % (NG * NP), g = gp / NP, p = gp % NP;
        unsigned char* base = F.ws + WS_S5P + (size_t)l * S5P_STRIDE;
        const double dt = exp((double)args.in[13][l * NG + g]);
        const double lr = (double)args.in[11][i], li = (double)args.in[12][i];
        const double mag = exp(lr * dt), ar = mag * cos(li * dt), ai = mag * sin(li * dt);
        const double nr = ar - 1.0, ni = ai, den = lr * lr + li * li;
        const double fr = (nr * lr + ni * li) / den, fi = (ni * lr - nr * li) / den;
        const double m32 = exp(32.0 * lr * dt), m128 = exp(128.0 * lr * dt);
        float* A = (float*)(base + S5P_A);
        A[0 * 1536 + gp] = (float)ar; A[1 * 1536 + gp] = (float)ai;
        A[2 * 1536 + gp] = (float)(m32 * cos(32.0 * li * dt)); A[3 * 1536 + gp] = (float)(m32 * sin(32.0 * li * dt));
        A[4 * 1536 + gp] = (float)(m128 * cos(128.0 * li * dt)); A[5 * 1536 + gp] = (float)(m128 * sin(128.0 * li * dt));
        { const double m1k = exp(1024.0 * lr * dt); A[6 * 1536 + gp] = (float)(m1k * cos(1024.0 * li * dt)); A[7 * 1536 + gp] = (float)(m1k * sin(1024.0 * li * dt)); }
        bf16* bm = (bf16*)(base + S5P_BMAT) + (size_t)g * 128 * 16;
        const float* bre = args.in[14] + (size_t)i * 16; const float* bim = args.in[15] + (size_t)i * 16;
        for (int c = 0; c < 16; ++c) { const double br = bre[c], bi = bim[c];
            bm[p * 16 + c] = f2bf1((float)(fr * br - fi * bi)); bm[(64 + p) * 16 + c] = f2bf1((float)(fr * bi + fi * br)); }
        bf16* cm = (bf16*)(base + S5P_CMAT) + (size_t)g * 16 * 128;
        const float* cre = args.in[16] + ((size_t)(l * NG + g) * 16) * NP; const float* cim = args.in[17] + ((size_t)(l * NG + g) * 16) * NP;
        for (int c = 0; c < 16; ++c) { cm[c * 128 + p] = f2bf1(cre[c * NP + p]); cm[c * 128 + 64 + p] = f2bf1(-cim[c * NP + p]); }
    }
    { f32x2* rope = (f32x2*)(F.ws + WS_ROPE);
      for (int i = gt; i < (PAST + STOK) * 8; i += NGT) { const int pos = i >> 3, k = i & 7; const double inv = pow(500000.0, -(double)k / 8.0), ang = (double)pos * inv;
          rope[i] = (f32x2){(float)cos(ang), (float)sin(ang)}; } }
    { bf16* XB = (bf16*)(F.ws + WS_XB); float* rss = (float*)(F.ws + WS_RSS);
      for (int row = gw; row < MR; row += NGW) {
          const float* xr = row < MP ? args.in[0] + (size_t)row * DM : args.in[1] + (size_t)(row - MP) * DM;
          const f32x4* x4 = (const f32x4*)xr + F.lane; float s = 0.f; f32x4 v[4];
#pragma unroll
          for (int j = 0; j < 4; ++j) { v[j] = x4[64 * j]; s += (v[j].x * v[j].x + v[j].y * v[j].y) + (v[j].z * v[j].z + v[j].w * v[j].w); }
          s = wave_sum(s);
          u32x2* o = (u32x2*)(XB + (size_t)row * DM) + F.lane;
#pragma unroll
          for (int j = 0; j < 4; ++j) o[64 * j] = (u32x2){cvtpk(v[j].x, v[j].y), cvtpk(v[j].z, v[j].w)};
          if (F.lane < 32) rss[(size_t)row * 32 + F.lane] = (F.lane == 0) ? s : 0.f;
      } }
}

DI int tok_of(int b, int r, int D, int i) { return b * SEQ + r + D * i; }

struct ApUnit { int br, b, h, D, r, J; };
DI ApUnit ap_decode(int unit) { ApUnit a; a.br = unit / 384; int rem = unit % 384; a.b = rem / 192; rem %= 192; a.h = rem / 32; const int blk = rem % 32;
    a.D = a.br == 0 ? 1 : (a.br == 1 ? 4 : 16); const int nper = (SEQ / a.D) / 256; a.r = blk / nper; a.J = blk % nper; return a; }
DI void ap_fetch(Frame& F, const ApUnit& a, u32x4 (&kr)[6], u32x4 (&vr)[6], bf16x8 (&qf)[4]) {
    const bf16* PROJ = (const bf16*)(F.ws + WS_PROJ); const int ibase = 256 * a.J - 128;
#pragma unroll
    for (int it = 0; it < 6; ++it) { const int id = F.tid + NTHR * it, kk = id >> 3, c = id & 7, i = ibase + kk;
        kr[it] = (u32x4){0u, 0u, 0u, 0u}; vr[it] = (u32x4){0u, 0u, 0u, 0u};
        if (i >= 0) { const bf16* rp = PROJ + (size_t)tok_of(a.b, a.r, a.D, i) * INW + a.h * HD + 8 * c; kr[it] = *(const u32x4*)(rp + O_K); vr[it] = *(const u32x4*)(rp + O_VV); } }
    const int qtok = tok_of(a.b, a.r, a.D, 256 * a.J + 32 * F.wave + (F.lane & 31));
#pragma unroll
    for (int s = 0; s < 4; ++s) qf[s] = *(const bf16x8*)(PROJ + (size_t)qtok * INW + O_Q + a.h * HD + 16 * s + 8 * (F.lane >> 5));
}
DI int ap_unit_of(int c, int i, int G, int count) {
    const int base = i * G, left = count - base;
    if (((G | left) & 7) != 0 || left >= 2 * G) { if (((G | (count % G)) & 7) != 0) { const int u = c + base; return u < count ? u : -1; } }
    if (left <= 0) return -1;
    const int n = left >= G ? G : left;
    return c < n ? base + (c & 7) * (n >> 3) + (c >> 3) : -1;
}
DI void attn_prompt_phase(Frame& F, int first, int count, int stride) {
    launder(F);
    int rnd = 0; int unit = ap_unit_of(first, 0, stride, count); if (unit < 0) return;
    LAS unsigned char* Ks = F.lds;
    LAS unsigned char* Vs = F.lds + 384 * 144;
    const int w = F.wave, l31 = F.lane & 31, hh = F.lane >> 5;
    u32x4 kr[6], vr[6]; bf16x8 qf[4];
    ApUnit a = ap_decode(unit); ap_fetch(F, a, kr, vr, qf);
    for (; unit >= 0; ) {
        const int nunit = ap_unit_of(first, ++rnd, stride, count);
#pragma unroll
        for (int it = 0; it < 6; ++it) { const int id = F.tid + NTHR * it, kk = id >> 3, c = id & 7; *(LAS u32x4*)(Ks + kk * 144 + c * 16) = kr[it]; *(LAS u32x4*)(Vs + kk * 144 + c * 16) = vr[it]; }
        const ApUnit cu = a; const int ibase = 256 * cu.J - 128;
        bf16x8 qc[4];
#pragma unroll
        for (int s = 0; s < 4; ++s) qc[s] = qf[s];
        __syncthreads();
        if (nunit >= 0) { a = ap_decode(nunit); ap_fetch(F, a, kr, vr, qf); }
        f32x16 S[5];
#pragma unroll
        for (int t = 0; t < 5; ++t) { S[t] = zero16(); bf16x8 kfr[4];
#pragma unroll
            for (int s = 0; s < 4; ++s) kfr[s] = *(const LAS bf16x8*)(Ks + (32 * w + 32 * t + l31) * 144 + (16 * s + 8 * hh) * 2);
            asm volatile("" : "+v"(kfr[0]), "+v"(kfr[1]), "+v"(kfr[2]), "+v"(kfr[3]));
#pragma unroll
            for (int s = 0; s < 4; ++s) S[t] = mfma32(kfr[s], qc[s], S[t]);
            __builtin_amdgcn_sched_barrier(0); }
        const float NEG = -3.0e38f;
        if (cu.J == 0) {
#pragma unroll
            for (int t = 0; t < 4; ++t)
#pragma unroll
                for (int rg = 0; rg < 16; ++rg) { if (32 * w + 32 * t + crow(rg, hh) < 128) S[t][rg] = NEG; }
        }
        float mx = NEG;
#pragma unroll
        for (int rg = 0; rg < 16; ++rg) { const int k0 = crow(rg, hh); S[0][rg] = (k0 >= l31) ? S[0][rg] : NEG; S[4][rg] = (k0 <= l31) ? S[4][rg] : NEG; }
#pragma unroll
        for (int t = 0; t < 5; ++t)
#pragma unroll
            for (int rg = 0; rg < 16; ++rg) mx = fmaxf(mx, S[t][rg]);
        mx = fmaxf(mx, __shfl_xor(mx, 32));
        const float c2 = 0.125f * 1.4426950409f, mc = mx * c2; float lsum = 0.f;
#pragma unroll
        for (int t = 0; t < 5; ++t)
#pragma unroll
            for (int rg = 0; rg < 16; ++rg) { const float pe = __builtin_amdgcn_exp2f(S[t][rg] * c2 - mc); S[t][rg] = pe; lsum += pe; }
        lsum += __shfl_xor(lsum, 32);
        f32x16 O[2]; O[0] = zero16(); O[1] = zero16();
        const int q4 = (F.lane & 15) >> 2, p4 = F.lane & 3, grp = (F.lane >> 4) & 1;
#pragma unroll
        for (int t = 0; t < 5; ++t)
#pragma unroll
            for (int s2 = 0; s2 < 2; ++s2) {
                u32x4 pw; pw.x = cvtpk(S[t][8 * s2 + 0], S[t][8 * s2 + 1]); pw.y = cvtpk(S[t][8 * s2 + 2], S[t][8 * s2 + 3]); pw.z = cvtpk(S[t][8 * s2 + 4], S[t][8 * s2 + 5]); pw.w = cvtpk(S[t][8 * s2 + 6], S[t][8 * s2 + 7]);
                const bf16x8 pf = __builtin_bit_cast(bf16x8, pw);
#pragma unroll
                for (int dt = 0; dt < 2; ++dt) {
                    LAS unsigned char* vp = Vs + (32 * w + 32 * t + 16 * s2 + 4 * hh + q4) * 144 + (32 * dt + 16 * grp) * 2 + 8 * p4;
                    const s16x4 lo = __builtin_bit_cast(s16x4, __builtin_amdgcn_ds_read_tr16_b64_v4i16((LAS s16x4*)vp));
                    const s16x4 hi4 = __builtin_bit_cast(s16x4, __builtin_amdgcn_ds_read_tr16_b64_v4i16((LAS s16x4*)(vp + 8 * 144)));
                    O[dt] = mfma32(__builtin_shufflevector(lo, hi4, 0, 1, 2, 3, 4, 5, 6, 7), pf, O[dt]);
                }
                __builtin_amdgcn_sched_barrier(0);
            }
        const float inv = 1.0f / lsum;
        const int qtok = tok_of(cu.b, cu.r, cu.D, 256 * cu.J + 32 * w + l31);
        bf16* OP = (bf16*)(F.ws + WS_OP) + ((size_t)cu.br * MP + qtok) * CWD + cu.h * HD;
#pragma unroll
        for (int dt = 0; dt < 2; ++dt)
#pragma unroll
            for (int g4 = 0; g4 < 4; ++g4) { u32x2 o; o.x = cvtpk(O[dt][4 * g4] * inv, O[dt][4 * g4 + 1] * inv); o.y = cvtpk(O[dt][4 * g4 + 2] * inv, O[dt][4 * g4 + 3] * inv);
                *(u32x2*)(OP + 32 * dt + 8 * g4 + 4 * hh) = o; }
        if (hh == 0) ((float*)(F.ws + WS_LSE))[((size_t)cu.br * MP + qtok) * CH + cu.h] = mx * 0.125f + __logf(lsum);
        __syncthreads();
        unit = nunit;
    }
}

DI void sgu_prompt_unit(const Args& args, Frame& F, int layer, int ch) {
    launder(F);
    const int R0 = (ch >> 6) * SEQ + (ch & 63) * 128;
    const bf16* PROJ = (const bf16*)(F.ws + WS_PROJ);
    LAS unsigned char* Vn = F.lds;
    const int w = F.wave, lane = F.lane, l31 = lane & 31, hh = lane >> 5;
    { u32x2 raw[16];
#pragma unroll
      for (int t = 0; t < 16; ++t) raw[t] = *(const u32x2*)(PROJ + (size_t)(R0 + 16 * w + t) * INW + O_V + 4 * lane);
#pragma unroll
      for (int t = 0; t < 16; ++t) {
          float v[4] = {__uint_as_float(raw[t].x << 16), __uint_as_float(raw[t].x & 0xffff0000u), __uint_as_float(raw[t].y << 16), __uint_as_float(raw[t].y & 0xffff0000u)};
          const float mean = wave_sum((v[0] + v[1]) + (v[2] + v[3])) * (1.0f / 256.0f);
          float q = 0.f;
#pragma unroll
          for (int e2 = 0; e2 < 4; ++e2) { v[e2] -= mean; q += v[e2] * v[e2]; }
          const float rstd = 1.0f / sqrtf(wave_sum(q) * (1.0f / 256.0f) + EPSN);
          *(LAS u32x2*)(Vn + (16 * w + t) * 528 + lane * 8) = (u32x2){cvtpk(v[0] * rstd, v[1] * rstd), cvtpk(v[2] * rstd, v[3] * rstd)}; } }
    const int hd = w >> 1, ih = w & 1;
    const bf16* Wm = (const bf16*)(F.ws + WS_WSM) + ((size_t)(layer * AH + hd) * 128) * 128;
    bf16x8 af[2][8];
#pragma unroll
    for (int s2 = 0; s2 < 8; ++s2)
#pragma unroll
        for (int mt = 0; mt < 2; ++mt) { const int sc_ = s2 < 4 * (ih + 1) ? s2 : 0; af[mt][s2] = *(const bf16x8*)(Wm + (size_t)(64 * ih + 32 * mt + l31) * 128 + 16 * sc_ + 8 * hh); }
    __syncthreads();
    f32x16 acc[2][2]; acc[0][0] = zero16(); acc[0][1] = zero16(); acc[1][0] = zero16(); acc[1][1] = zero16();
    const int q4 = (lane & 15) >> 2, p4 = lane & 3, grp = (lane >> 4) & 1;
#pragma unroll
    for (int s2 = 0; s2 < 8; ++s2) if (s2 < 4 * (ih + 1)) {
        bf16x8 bfr[2];
#pragma unroll
        for (int nt = 0; nt < 2; ++nt) {
            LAS unsigned char* vp = Vn + (16 * s2 + 8 * hh + q4) * 528 + (64 * hd + 32 * nt + 16 * grp) * 2 + 8 * p4;
            const s16x4 lo = __builtin_bit_cast(s16x4, __builtin_amdgcn_ds_read_tr16_b64_v4i16((LAS s16x4*)vp));
            const s16x4 hi4 = __builtin_bit_cast(s16x4, __builtin_amdgcn_ds_read_tr16_b64_v4i16((LAS s16x4*)(vp + 4 * 528)));
            bfr[nt] = __builtin_shufflevector(lo, hi4, 0, 1, 2, 3, 4, 5, 6, 7); }
#pragma unroll
        for (int mt = 0; mt < 2; ++mt)
#pragma unroll
            for (int nt = 0; nt < 2; ++nt) acc[mt][nt] = mfma32(af[mt][s2], bfr[nt], acc[mt][nt]);
    }
    const float* bs = args.in[10] + (size_t)(layer * AH + hd) * 128;
    f32x4 bq[2][4];
#pragma unroll
    for (int mt = 0; mt < 2; ++mt)
#pragma unroll
        for (int q = 0; q < 4; ++q) bq[mt][q] = *(const f32x4*)(bs + 64 * ih + 32 * mt + 8 * q + 4 * hh);
    __syncthreads();
    asm volatile("" : "+v"(bq[0][0]), "+v"(bq[0][1]), "+v"(bq[0][2]), "+v"(bq[0][3]), "+v"(bq[1][0]), "+v"(bq[1][1]), "+v"(bq[1][2]), "+v"(bq[1][3]));
#pragma unroll
    for (int mt = 0; mt < 2; ++mt)
#pragma unroll
        for (int rg = 0; rg < 16; ++rg) { const int i = 64 * ih + 32 * mt + crow(rg, hh); const float bb = bq[mt][rg >> 2][rg & 3];
#pragma unroll
            for (int nt = 0; nt < 2; ++nt) *(LAS unsigned short*)(Vn + i * 528 + (64 * hd + 32 * nt + l31) * 2) = f2bf1(acc[mt][nt][rg] + bb); }
    bf16* MIX = (bf16*)(F.ws + WS_MIX);
    int tid2 = F.tid; asm volatile("" : "+v"(tid2));
    u32x4 uu8[8];
#pragma unroll
    for (int it = 0; it < 8; ++it) { const int id = tid2 + NTHR * it, row = id >> 5, c = id & 31; uu8[it] = *(const u32x4*)(PROJ + (size_t)(R0 + row) * INW + O_U + 8 * c); }
    __syncthreads();
    asm volatile("" : "+v"(uu8[0]), "+v"(uu8[1]), "+v"(uu8[2]), "+v"(uu8[3]), "+v"(uu8[4]), "+v"(uu8[5]), "+v"(uu8[6]), "+v"(uu8[7]));
#pragma unroll
    for (int it = 0; it < 8; ++it) { const int id = tid2 + NTHR * it, row = id >> 5, c = id & 31;
        const u32x4 uu = uu8[it], mm = *(const LAS u32x4*)(Vn + row * 528 + c * 16);
        u32x4 o;
#pragma unroll
        for (int e2 = 0; e2 < 4; ++e2) o[e2] = cvtpk(__uint_as_float(uu[e2] << 16) * __uint_as_float(mm[e2] << 16), __uint_as_float(uu[e2] & 0xffff0000u) * __uint_as_float(mm[e2] & 0xffff0000u));
        *(u32x4*)(MIX + (size_t)(R0 + row) * DM + 8 * c) = o; }
    __syncthreads();
}

struct S5W { bf16x8 bfr[4]; float ar0, ai0, ar1, ai1; };
DI void s5_load_group(Frame& F, int layer, int g, S5W& W) {
    const unsigned char* base = F.ws + WS_S5P + (size_t)layer * S5P_STRIDE; const int l31 = F.lane & 31, hh = F.lane >> 5;
    const bf16* bm = (const bf16*)(base + S5P_BMAT) + (size_t)g * 128 * 16;
#pragma unroll
    for (int nt = 0; nt < 4; ++nt) W.bfr[nt] = *(const bf16x8*)(bm + (32 * nt + l31) * 16 + 8 * hh);
    const float* A = (const float*)(base + S5P_A);
    W.ar0 = A[g * NP + l31]; W.ai0 = A[1536 + g * NP + l31]; W.ar1 = A[g * NP + 32 + l31]; W.ai1 = A[1536 + g * NP + 32 + l31];
}
DI bf16x8 s5_afrag(Frame& F, int g, int tbase) {
    const bf16* PROJ = (const bf16*)(F.ws + WS_PROJ); const int l31 = F.lane & 31, hh = F.lane >> 5;
    const int tt = (l31 & 3) + 4 * (l31 >> 3), bb = (l31 >> 2) & 1;
    return *(const bf16x8*)(PROJ + (size_t)(bb * SEQ + tbase + tt) * INW + O_S5 + 16 * g + 8 * hh);
}
DI void s5_tile(const S5W& W, const bf16x8 af, f32x16 (&X)[4], float& hr0, float& hi0, float& hr1, float& hi1) {
#pragma unroll
    for (int nt = 0; nt < 4; ++nt) X[nt] = mfma32(af, W.bfr[nt], zero16());
#pragma unroll
    for (int rg = 0; rg < 16; ++rg) {
        const float nr0 = W.ar0 * hr0 - W.ai0 * hi0 + X[0][rg], ni0 = W.ar0 * hi0 + W.ai0 * hr0 + X[2][rg];
        const float nr1 = W.ar1 * hr1 - W.ai1 * hi1 + X[1][rg], ni1 = W.ar1 * hi1 + W.ai1 * hr1 + X[3][rg];
        hr0 = nr0; hi0 = ni0; hr1 = nr1; hi1 = ni1; X[0][rg] = nr0; X[2][rg] = ni0; X[1][rg] = nr1; X[3][rg] = ni1;
    }
}
DI void cmul_acc(float& hr, float& hi, float ar, float ai, float xr, float xi) { const float nr = ar * hr - ai * hi + xr, ni = ar * hi + ai * hr + xi; hr = nr; hi = ni; }
DI void s5_pass1_unit(Frame& F, int layer, int S, int g) {
    launder(F);
    S5W W; s5_load_group(F, layer, g, W);
    const int l31 = F.lane & 31, hh = F.lane >> 5, w = F.wave, C = 8 * S + w;
    float hr0 = 0.f, hi0 = 0.f, hr1 = 0.f, hi1 = 0.f;
    f32x2* L = (f32x2*)(F.ws + WS_S5L);
    bf16x8 afs[8];
#pragma unroll
    for (int k = 0; k < 8; ++k) afs[k] = s5_afrag(F, g, 128 * C + 16 * k);
    asm volatile("" : "+v"(afs[0]), "+v"(afs[1]), "+v"(afs[2]), "+v"(afs[3]), "+v"(afs[4]), "+v"(afs[5]), "+v"(afs[6]), "+v"(afs[7]));
#pragma unroll
    for (int k = 0; k < 8; ++k) {
        f32x16 X[4]; s5_tile(W, afs[k], X, hr0, hi0, hr1, hi1);
        if (k & 1) { const size_t idx = ((((size_t)C * 4 + (k >> 1)) * 2 + hh) * NG + g) * NP + l31; L[idx] = (f32x2){hr0, hi0}; L[idx + 32] = (f32x2){hr1, hi1}; }
    }
    LAS f32x4* es = (LAS f32x4*)F.lds;
    es[w * 64 + F.lane] = (f32x4){hr0, hi0, hr1, hi1};
    __syncthreads();
    const float* A = (const float*)(F.ws + WS_S5P + (size_t)layer * S5P_STRIDE + S5P_A);
    const float br0 = A[4 * 1536 + g * NP + l31], bi0 = A[5 * 1536 + g * NP + l31], br1 = A[4 * 1536 + g * NP + 32 + l31], bi1 = A[5 * 1536 + g * NP + 32 + l31];
    float pr0 = 0.f, pi0 = 0.f, pr1 = 0.f, pi1 = 0.f;
    for (int q = 0; q < w; ++q) { const f32x4 e = es[q * 64 + F.lane]; cmul_acc(pr0, pi0, br0, bi0, e.x, e.y); cmul_acc(pr1, pi1, br1, bi1, e.z, e.w); }
    { f32x2* PW = (f32x2*)(F.ws + WS_S5PW); const size_t idx = (((size_t)C * 2 + hh) * NG + g) * NP + l31; PW[idx] = (f32x2){pr0, pi0}; PW[idx + 32] = (f32x2){pr1, pi1}; }
    if (w == 7) { cmul_acc(pr0, pi0, br0, bi0, hr0, hi0); cmul_acc(pr1, pi1, br1, bi1, hr1, hi1);
        f32x2* SE = (f32x2*)(F.ws + WS_S5SE); const size_t idx = (((size_t)S * 2 + hh) * NG + g) * NP + l31; SE[idx] = (f32x2){pr0, pi0}; SE[idx + 32] = (f32x2){pr1, pi1}; }
    __syncthreads();
}

DI void sgu_sample_unit(const Args& args, Frame& F, int layer, int sb) {
    launder(F);
    const bf16* PROJ = (const bf16*)(F.ws + WS_PROJ); const int R0 = MP + sb * STOK;
    LAS float* vn = (LAS float*)F.lds;
    { const int t = F.wave; const bf16* vr = PROJ + (size_t)(R0 + t) * INW + O_V + 4 * F.lane;
      const u32x2 rw = *(const u32x2*)vr; float v[4] = {__uint_as_float(rw.x << 16), __uint_as_float(rw.x & 0xffff0000u), __uint_as_float(rw.y << 16), __uint_as_float(rw.y & 0xffff0000u)};
      const float mean = wave_sum((v[0] + v[1]) + (v[2] + v[3])) * (1.0f / 256.0f);
      float q = 0.f;
#pragma unroll
      for (int e = 0; e < 4; ++e) { v[e] -= mean; q += v[e] * v[e]; }
      const float rstd = 1.0f / sqrtf(wave_sum(q) * (1.0f / 256.0f) + EPSN);
      float* sg = F.out + OUT_SGV + ((size_t)(layer * SBATCH + sb) * STOK + t) * AW + 4 * F.lane;
#pragma unroll
      for (int e = 0; e < 4; ++e) { v[e] *= rstd; vn[t * 256 + 4 * F.lane + e] = v[e]; }
      *(f32x4*)sg = (f32x4){v[0], v[1], v[2], v[3]}; }
    __syncthreads();
    bf16* MIX = (bf16*)(F.ws + WS_MIX);
#pragma unroll
    for (int q = 0; q < 4; ++q) { const int o = F.tid + NTHR * q, i = o >> 8, col = o & 255, hd = col >> 6;
        const float* wr = args.in[9] + ((size_t)(layer * AH + hd) * 128 + i) * 128;
        const f32x4 w0 = *(const f32x4*)wr, w1 = *(const f32x4*)(wr + 4);
        float a = args.in[10][(size_t)(layer * AH + hd) * 128 + i];
        const float wv[8] = {w0.x, w0.y, w0.z, w0.w, w1.x, w1.y, w1.z, w1.w};
#pragma unroll
        for (int j = 0; j < 8; ++j) a += (j <= i ? wv[j] : 0.f) * vn[j * 256 + col];
        const float uu = bf2f(PROJ[(size_t)(R0 + i) * INW + O_U + col]);
        MIX[(size_t)(R0 + i) * DM + col] = f2bf1(uu * a); }
    __syncthreads();
}

DI void s5_sample_unit(const Args& args, Frame& F, int layer, int unit) {
    launder(F);
    const int sb = unit / 3, part = unit % 3, g = 8 * part + F.wave, p = F.lane;
    const bf16* PROJ = (const bf16*)(F.ws + WS_PROJ); const int R0 = MP + sb * STOK;
    const unsigned char* base = F.ws + WS_S5P + (size_t)layer * S5P_STRIDE;
    LAS float* us = (LAS float*)F.lds;
    LAS float* hw = us + 8 * 384 + F.wave * (8 * 64 * 2);
    LAS float* cms = us + 8 * 384 + 8 * (8 * 64 * 2) + F.wave * (16 * 128);
    { const bf16* cm = (const bf16*)(base + S5P_CMAT) + (size_t)g * 16 * 128;
      unsigned uv[6]; u32x4 rwq[4];
#pragma unroll
      for (int q = 0; q < 6; ++q) { const int i = F.tid + NTHR * q, t = i / 384, c = i % 384; uv[q] = PROJ[(size_t)(R0 + t) * INW + O_S5 + c]; }
#pragma unroll
      for (int q = 0; q < 4; ++q) rwq[q] = *(const u32x4*)(cm + 8 * (p + 64 * q));
      asm volatile("" : "+v"(uv[0]), "+v"(uv[1]), "+v"(uv[2]), "+v"(uv[3]), "+v"(uv[4]), "+v"(uv[5]), "+v"(rwq[0]), "+v"(rwq[1]), "+v"(rwq[2]), "+v"(rwq[3]));
#pragma unroll
      for (int q = 0; q < 6; ++q) us[F.tid + NTHR * q] = __uint_as_float(uv[q] << 16);
#pragma unroll
      for (int q = 0; q < 4; ++q) { const int ch = p + 64 * q; const u32x4 rw = rwq[q];
#pragma unroll
          for (int e2 = 0; e2 < 4; ++e2) { cms[8 * ch + 2 * e2] = __uint_as_float(rw[e2] << 16); cms[8 * ch + 2 * e2 + 1] = __uint_as_float(rw[e2] & 0xffff0000u); } } }
    __syncthreads();
    const bf16* bm = (const bf16*)(base + S5P_BMAT) + (size_t)g * 128 * 16;
    const float* A = (const float*)(base + S5P_A);
    const float ar = A[g * NP + p], ai = A[1536 + g * NP + p];
    float bre[16], bim[16];
    { const u32x4* b0 = (const u32x4*)(bm + p * 16); const u32x4* b1 = (const u32x4*)(bm + (64 + p) * 16);
#pragma unroll
      for (int q = 0; q < 2; ++q) { const u32x4 x = b0[q], y = b1[q];
#pragma unroll
          for (int e2 = 0; e2 < 4; ++e2) { bre[8 * q + 2 * e2] = __uint_as_float(x[e2] << 16); bre[8 * q + 2 * e2 + 1] = __uint_as_float(x[e2] & 0xffff0000u);
                                          bim[8 * q + 2 * e2] = __uint_as_float(y[e2] << 16); bim[8 * q + 2 * e2 + 1] = __uint_as_float(y[e2] & 0xffff0000u); } } }
    const size_t sidx = ((size_t)(layer * SBATCH + sb) * NG + g) * NP + p;
    float hr = args.in[4][sidx], hi = args.in[5][sidx];
#pragma unroll
    for (int t = 0; t < 8; ++t) {
        float xr = 0.f, xi = 0.f;
#pragma unroll
        for (int c = 0; c < 16; ++c) { const float uu = us[t * 384 + 16 * g + c]; xr += bre[c] * uu; xi += bim[c] * uu; }
        const float nr = ar * hr - ai * hi + xr, ni = ar * hi + ai * hr + xi; hr = nr; hi = ni;
        hw[(t * 64 + p) * 2] = hr; hw[(t * 64 + p) * 2 + 1] = hi;
    }
    F.out[OUT_SRS + sidx] = hr; F.out[OUT_SIS + sidx] = hi;
    LDS_WAIT(); asm volatile("" ::: "memory");
    { const int t = F.lane >> 3, c0 = F.lane & 7;
      float y0 = 0.f, y1 = 0.f;
#pragma unroll 8
      for (int pp = 0; pp < 64; ++pp) { const float hre = hw[(t * 64 + pp) * 2], him = hw[(t * 64 + pp) * 2 + 1];
          y0 += cms[c0 * 128 + pp] * hre + cms[c0 * 128 + 64 + pp] * him;
          y1 += cms[(c0 + 8) * 128 + pp] * hre + cms[(c0 + 8) * 128 + 64 + pp] * him; }
      const float* dsk = args.in[18] + (size_t)layer * BW + 16 * g;
      y0 += dsk[c0] * us[t * 384 + 16 * g + c0]; y1 += dsk[c0 + 8] * us[t * 384 + 16 * g + c0 + 8];
      bf16* gsm = (bf16*)(F.ws + WS_GSMP) + (size_t)(sb * STOK + t) * BW + 16 * g;
      gsm[c0] = f2bf1(gelu_t(y0)); gsm[c0 + 8] = f2bf1(gelu_t(y1)); }
    __syncthreads();
}

DI float row16_sum(float x) {
    x += __builtin_bit_cast(float, __builtin_amdgcn_update_dpp(0, __builtin_bit_cast(int, x), 0x128, 0xf, 0xf, false));
    x += __builtin_bit_cast(float, __builtin_amdgcn_update_dpp(0, __builtin_bit_cast(int, x), 0x124, 0xf, 0xf, false));
    x += __builtin_bit_cast(float, __builtin_amdgcn_update_dpp(0, __builtin_bit_cast(int, x), 0x122, 0xf, 0xf, false));
    x += __builtin_bit_cast(float, __builtin_amdgcn_update_dpp(0, __builtin_bit_cast(int, x), 0x121, 0xf, 0xf, false));
    return x;
}
DI void attn_sample_unit(const Args& args, Frame& F, int layer, int unit) {
    launder(F);
    const int br = unit / 192, rem = unit % 192, sb = rem / CH, h = rem % CH, i = F.wave, lane = F.lane;
    const int dil = br == 0 ? 1 : (br == 1 ? 4 : 16);
    const int rg = lane >> 4, dq = lane & 15;
    const bf16* PROJ = (const bf16*)(F.ws + WS_PROJ); const int R0 = MP + sb * STOK;
    float q4[4];
#pragma unroll
    for (int e = 0; e < 4; ++e) q4[e] = 0.125f * bf2f(PROJ[(size_t)(R0 + i) * INW + O_Q + h * HD + rope_phys(4 * dq + e)]);
    const float* ck = args.in[2] + ((size_t)(layer * SBATCH + sb) * CWIN) * CWD + h * HD + 4 * dq;
    const float* cv = args.in[3] + ((size_t)(layer * SBATCH + sb) * CWIN) * CWD + h * HD + 4 * dq;
    const float* nk = F.out + OUT_KS + ((size_t)(layer * MS + sb * STOK) * CH + h) * HD + 4 * dq;
    const float* nv = F.out + OUT_VS + ((size_t)(layer * MS + sb * STOK) * CH + h) * HD + 4 * dq;
    float sc[33];
#define AS_KROW(jb) ({ const int j_ = 4 * (jb) + rg, jc_ = j_ > 128 ? 128 : j_, kp_ = PAST + i - dil * jc_; (kp_ < PAST) ? ck + (size_t)(kp_ - (PAST - CWIN)) * CWD : nk + (size_t)(kp_ - PAST) * CWD; })
#define AS_VROW(jb) ({ const int j_ = 4 * (jb) + rg, jc_ = j_ > 128 ? 128 : j_, kp_ = PAST + i - dil * jc_; (kp_ < PAST) ? cv + (size_t)(kp_ - (PAST - CWIN)) * CWD : nv + (size_t)(kp_ - PAST) * CWD; })
    { f32x4 ka[17];
#pragma unroll
      for (int jb = 0; jb < 17; ++jb) ka[jb] = *(const f32x4*)AS_KROW(jb);
      f32x4 kb[16];
#pragma unroll
      for (int jb = 0; jb < 16; ++jb) kb[jb] = *(const f32x4*)AS_KROW(17 + jb);
#pragma unroll
      for (int jb = 0; jb < 17; ++jb) sc[jb] = row16_sum(ka[jb].x * q4[0] + ka[jb].y * q4[1] + ka[jb].z * q4[2] + ka[jb].w * q4[3]);
#pragma unroll
      for (int jb = 0; jb < 16; ++jb) sc[17 + jb] = row16_sum(kb[jb].x * q4[0] + kb[jb].y * q4[1] + kb[jb].z * q4[2] + kb[jb].w * q4[3]); }
    if (rg != 0) sc[32] = -3.0e38f;
    f32x4 va[17];
#pragma unroll
    for (int jb = 0; jb < 17; ++jb) va[jb] = *(const f32x4*)AS_VROW(jb);
    float mx = sc[0];
#pragma unroll
    for (int jb = 1; jb < 33; ++jb) mx = fmaxf(mx, sc[jb]);
    mx = fmaxf(mx, __shfl_xor(mx, 16)); mx = fmaxf(mx, __shfl_xor(mx, 32));
    float lsum = 0.f;
#pragma unroll
    for (int jb = 0; jb < 33; ++jb) { sc[jb] = __expf(sc[jb] - mx); lsum += sc[jb]; }
    lsum += __shfl_xor(lsum, 16); lsum += __shfl_xor(lsum, 32);
    f32x4 o = (f32x4){0.f, 0.f, 0.f, 0.f};
    f32x4 vb[16];
#pragma unroll
    for (int jb = 0; jb < 16; ++jb) vb[jb] = *(const f32x4*)AS_VROW(17 + jb);
#pragma unroll
    for (int jb = 0; jb < 17; ++jb) { o.x += sc[jb] * va[jb].x; o.y += sc[jb] * va[jb].y; o.z += sc[jb] * va[jb].z; o.w += sc[jb] * va[jb].w; }
#pragma unroll
    for (int jb = 0; jb < 16; ++jb) { o.x += sc[17 + jb] * vb[jb].x; o.y += sc[17 + jb] * vb[jb].y; o.z += sc[17 + jb] * vb[jb].z; o.w += sc[17 + jb] * vb[jb].w; }
#undef AS_KROW
#undef AS_VROW
#pragma unroll
    for (int e = 0; e < 4; ++e) { o[e] += __shfl_xor(o[e], 16); o[e] += __shfl_xor(o[e], 32); }
    const float inv = 1.0f / lsum;
    const int row = sb * STOK + i;
    if (rg == 0) *(f32x4*)((float*)(F.ws + WS_OPS) + ((size_t)br * MS + row) * CWD + h * HD + 4 * dq) = (f32x4){o.x * inv, o.y * inv, o.z * inv, o.w * inv};
    if (lane == 0) ((float*)(F.ws + WS_LSES))[((size_t)br * MS + row) * CH + h] = mx + __logf(lsum);
}

DI void attn_merge(Frame& F) {
    launder(F);
    const bf16* OP = (const bf16*)(F.ws + WS_OP); const float* LSE = (const float*)(F.ws + WS_LSE); bf16* MIX = (bf16*)(F.ws + WS_MIX);
    const int gt = F.bid * NTHR + F.tid, NGT = F.G * NTHR;
    constexpr int NT = MP * CH * 8;
    for (int i0 = gt; i0 < NT; i0 += 2 * NGT) {
        float lw[2][3]; u32x4 pa[2][3]; int dst[2]; bool on[2];
#pragma unroll
        for (int k = 0; k < 2; ++k) { const int i = i0 + k * NGT; on[k] = i < NT; const int ic = on[k] ? i : i0; const int c = ic & 7, th = ic >> 3, h = th % CH, tok = th / CH;
            dst[k] = tok * DM + AW + BW + h * HD + 8 * c;
#pragma unroll
            for (int b = 0; b < 3; ++b) { lw[k][b] = LSE[((size_t)b * MP + tok) * CH + h]; pa[k][b] = *(const u32x4*)(OP + ((size_t)b * MP + tok) * CWD + h * HD + 8 * c); } }
#pragma unroll
        for (int k = 0; k < 2; ++k) if (on[k]) {
            const float ml = fmaxf(fmaxf(lw[k][0], lw[k][1]), lw[k][2]); float w0 = __expf(lw[k][0] - ml), w1 = __expf(lw[k][1] - ml), w2 = __expf(lw[k][2] - ml); const float iw = 1.0f / (w0 + w1 + w2); w0 *= iw; w1 *= iw; w2 *= iw;
            u32x4 o;
#pragma unroll
            for (int e2 = 0; e2 < 4; ++e2) { const float lo = w0 * __uint_as_float(pa[k][0][e2] << 16) + w1 * __uint_as_float(pa[k][1][e2] << 16) + w2 * __uint_as_float(pa[k][2][e2] << 16);
                const float hi2 = w0 * __uint_as_float(pa[k][0][e2] & 0xffff0000u) + w1 * __uint_as_float(pa[k][1][e2] & 0xffff0000u) + w2 * __uint_as_float(pa[k][2][e2] & 0xffff0000u); o[e2] = cvtpk(lo, hi2); }
            *(u32x4*)(MIX + (size_t)dst[k]) = o; }
    }
}

typedef float f32x4v __attribute__((ext_vector_type(4)));
DI void glu_tile(const Args& args, Frame& F, int layer, LAS unsigned char* Gs, int t0) {
    const int l15 = F.lane & 15, q4 = F.lane >> 4, w = F.wave;
    __syncthreads();
    const bf16* wg = (const bf16*)(F.ws + WS_WGLU + (size_t)layer * WGLU_STRIDE) + (size_t)(48 * w + l15) * BW + 8 * q4;
    f32x4v acc[4][3];
#pragma unroll
    for (int mt = 0; mt < 4; ++mt)
#pragma unroll
        for (int nt = 0; nt < 3; ++nt) acc[mt][nt] = (f32x4v){0.f, 0.f, 0.f, 0.f};
#pragma unroll 3
    for (int s = 0; s < 12; ++s) {
        bf16x8 a[4], b[3];
#pragma unroll
        for (int nt = 0; nt < 3; ++nt) b[nt] = *(const bf16x8*)(wg + (size_t)(16 * nt) * BW + 32 * s);
#pragma unroll
        for (int mt = 0; mt < 4; ++mt) a[mt] = *(const LAS bf16x8*)(Gs + (16 * mt + l15) * 784 + (32 * s + 8 * q4) * 2);
#pragma unroll
        for (int mt = 0; mt < 4; ++mt)
#pragma unroll
            for (int nt = 0; nt < 3; ++nt) acc[mt][nt] = __builtin_amdgcn_mfma_f32_16x16x32_bf16(a[mt], b[nt], acc[mt][nt], 0, 0, 0);
    }
    const float* bg = args.in[20] + (size_t)layer * BW;
    float bb3[3];
#pragma unroll
    for (int nt = 0; nt < 3; ++nt) bb3[nt] = bg[48 * w + 16 * nt + l15];
    __syncthreads();
    asm volatile("" : "+v"(bb3[0]), "+v"(bb3[1]), "+v"(bb3[2]));
#pragma unroll
    for (int nt = 0; nt < 3; ++nt) { const int n = 48 * w + 16 * nt + l15; const float bb = bb3[nt]; unsigned short gr[16];
#pragma unroll
        for (int mt = 0; mt < 4; ++mt)
#pragma unroll
            for (int r = 0; r < 4; ++r) gr[4 * mt + r] = *(const LAS unsigned short*)(Gs + (16 * mt + 4 * q4 + r) * 784 + n * 2);
#pragma unroll
        for (int mt = 0; mt < 4; ++mt)
#pragma unroll
            for (int r = 0; r < 4; ++r) *(LAS unsigned short*)(Gs + (16 * mt + 4 * q4 + r) * 784 + n * 2) = f2bf1(bf2f(gr[4 * mt + r]) * sigmoid_f(acc[mt][nt][r] + bb)); }
    __syncthreads();
    bf16* MIX = (bf16*)(F.ws + WS_MIX);
    int tid2 = F.tid; asm volatile("" : "+v"(tid2));
#pragma unroll
    for (int it = 0; it < 6; ++it) { const int id = tid2 + NTHR * it, r = id / 48, c = id % 48, tok = (r >> 5) * SEQ + t0 + (r & 31);
        *(u32x4*)(MIX + (size_t)tok * DM + AW + 8 * c) = *(const LAS u32x4*)(Gs + r * 784 + c * 16); }
    __syncthreads();
}

DI void attn_sample_merge(Frame& F) {
    launder(F);
    const float* OPS = (const float*)(F.ws + WS_OPS); const float* LS = (const float*)(F.ws + WS_LSES); bf16* MIX = (bf16*)(F.ws + WS_MIX);
    const int gt = F.bid * NTHR + F.tid, NGT = F.G * NTHR;
    for (int i = gt; i < MS * CH * 16; i += NGT) { const int dq = i & 15, rh = i >> 4, h = rh % CH, row = rh / CH;
        const float l0 = LS[(size_t)row * CH + h], l1 = LS[((size_t)MS + row) * CH + h], l2 = LS[((size_t)2 * MS + row) * CH + h];
        const float ml = fmaxf(fmaxf(l0, l1), l2); float w0 = __expf(l0 - ml), w1 = __expf(l1 - ml), w2 = __expf(l2 - ml); const float iw = 1.0f / (w0 + w1 + w2); w0 *= iw; w1 *= iw; w2 *= iw;
        const f32x4 a = *(const f32x4*)(OPS + (size_t)row * CWD + h * HD + 4 * dq), b = *(const f32x4*)(OPS + ((size_t)MS + row) * CWD + h * HD + 4 * dq), d = *(const f32x4*)(OPS + ((size_t)2 * MS + row) * CWD + h * HD + 4 * dq);
        u32x2 o; o.x = cvtpk(w0 * a.x + w1 * b.x + w2 * d.x, w0 * a.y + w1 * b.y + w2 * d.y); o.y = cvtpk(w0 * a.z + w1 * b.z + w2 * d.z, w0 * a.w + w1 * b.w + w2 * d.w);
        *(u32x2*)(MIX + (size_t)(MP + row) * DM + AW + BW + h * HD + 4 * dq) = o; }
}


struct S5G { S5W W; bf16x8 cf[8]; float dsk; };
DI void s5_load_group2(const Args& args, Frame& F, int layer, int g, S5G& G) {
    s5_load_group(F, layer, g, G.W);
    const unsigned char* base = F.ws + WS_S5P + (size_t)layer * S5P_STRIDE; const int l31 = F.lane & 31, hh = F.lane >> 5;
    const bf16* cm = (const bf16*)(base + S5P_CMAT) + (size_t)g * 16 * 128;
    const int lc = l31 & 15;
#pragma unroll
    for (int s = 0; s < 8; ++s) { u32x4 z = *(const u32x4*)(cm + lc * 128 + 16 * s + 8 * hh); if (l31 >= 16) z = (u32x4){0u, 0u, 0u, 0u}; G.cf[s] = __builtin_bit_cast(bf16x8, z); }
    G.dsk = args.in[18][(size_t)layer * BW + 16 * g + lc];
}
DI void s5_carry(Frame& F, int layer, int g, int C, int j, float& hr0, float& hi0, float& hr1, float& hi1) {
    const int l31 = F.lane & 31, hh = F.lane >> 5;
    const float* A = (const float*)(F.ws + WS_S5P + (size_t)layer * S5P_STRIDE + S5P_A);
    const f32x2* L = (const f32x2*)(F.ws + WS_S5L);
    hr0 = 0.f; hi0 = 0.f; hr1 = 0.f; hi1 = 0.f;
    const int Ssup = C >> 3, wch = C & 7;
    const float kr0 = A[6 * 1536 + g * NP + l31], ki0 = A[7 * 1536 + g * NP + l31], kr1 = A[6 * 1536 + g * NP + 32 + l31], ki1 = A[7 * 1536 + g * NP + 32 + l31];
    const f32x2* SE = (const f32x2*)(F.ws + WS_S5SE); f32x2 e0[7], e1[7];
#pragma unroll
    for (int q = 0; q < 7; ++q) { const int sq = q < Ssup ? q : 0; const size_t idx = (((size_t)sq * 2 + hh) * NG + g) * NP + l31; e0[q] = SE[idx]; e1[q] = SE[idx + 32]; }
    const f32x2* PW = (const f32x2*)(F.ws + WS_S5PW); const size_t pidx = (((size_t)C * 2 + hh) * NG + g) * NP + l31; const f32x2 pw0 = PW[pidx], pw1 = PW[pidx + 32];
    const int jm = j > 0 ? j - 1 : 0; const size_t lidx = ((((size_t)C * 4 + jm) * 2 + hh) * NG + g) * NP + l31; const f32x2 l0 = L[lidx], l1 = L[lidx + 32];
    const float br0 = A[4 * 1536 + g * NP + l31], bi0 = A[5 * 1536 + g * NP + l31], br1 = A[4 * 1536 + g * NP + 32 + l31], bi1 = A[5 * 1536 + g * NP + 32 + l31];
    const float cr0 = A[2 * 1536 + g * NP + l31], ci0 = A[3 * 1536 + g * NP + l31], cr1 = A[2 * 1536 + g * NP + 32 + l31], ci1 = A[3 * 1536 + g * NP + 32 + l31];
#pragma unroll
    for (int q = 0; q < 7; ++q) if (q < Ssup) { cmul_acc(hr0, hi0, kr0, ki0, e0[q].x, e0[q].y); cmul_acc(hr1, hi1, kr1, ki1, e1[q].x, e1[q].y); }
    for (int q = 0; q < wch; ++q) { cmul_acc(hr0, hi0, br0, bi0, 0.f, 0.f); cmul_acc(hr1, hi1, br1, bi1, 0.f, 0.f); }
    hr0 += pw0.x; hi0 += pw0.y; hr1 += pw1.x; hi1 += pw1.y;
    if (j > 0) { for (int q = 0; q < j; ++q) { cmul_acc(hr0, hi0, cr0, ci0, 0.f, 0.f); cmul_acc(hr1, hi1, cr1, ci1, 0.f, 0.f); }
        hr0 += l0.x; hi0 += l0.y; hr1 += l1.x; hi1 += l1.y; }
}
DI void s5_pass2_unit(const Args& args, Frame& F, int layer, int sc) {
    launder(F);
    const int C = sc >> 2, j = sc & 3, t0 = 32 * sc;
    const bf16* PROJ = (const bf16*)(F.ws + WS_PROJ);
    const int l31 = F.lane & 31, hh = F.lane >> 5, w = F.wave;
    LAS unsigned char* img = F.lds + w * 8192;
    LAS unsigned char* Gs = F.lds + 65536;
    u32x4 ut[6];
#pragma unroll
    for (int it = 0; it < 6; ++it) { const int id = F.tid + NTHR * it, r = id / 48, c = id % 48;
        ut[it] = *(const u32x4*)(PROJ + (size_t)((r >> 5) * SEQ + t0 + (r & 31)) * INW + O_S5 + 8 * c); }
    asm volatile("" : "+v"(ut[0]), "+v"(ut[1]), "+v"(ut[2]), "+v"(ut[3]), "+v"(ut[4]), "+v"(ut[5]));
#pragma unroll
    for (int it = 0; it < 6; ++it) { const int id = F.tid + NTHR * it, r = id / 48, c = id % 48; *(LAS u32x4*)(Gs + r * 784 + c * 16) = ut[it]; }
    float cr[3][4];
#pragma unroll
    for (int gi = 0; gi < 3; ++gi) s5_carry(F, layer, 3 * w + gi, C, j, cr[gi][0], cr[gi][1], cr[gi][2], cr[gi][3]);
    S5G Gn; s5_load_group2(args, F, layer, 3 * w, Gn);
    __syncthreads();
    const int tt = (l31 & 3) + 4 * (l31 >> 3), bb = (l31 >> 2) & 1;
#pragma unroll
    for (int gi = 0; gi < 3; ++gi) {
        const int g = 3 * w + gi;
        const S5G G = Gn;
        if (gi < 2) s5_load_group2(args, F, layer, g + 1, Gn);
        float hr0 = cr[gi][0], hi0 = cr[gi][1], hr1 = cr[gi][2], hi1 = cr[gi][3];
#pragma unroll 1
        for (int k = 0; k < 2; ++k) {
            const bf16x8 af = *(const LAS bf16x8*)(Gs + (32 * bb + 16 * k + tt) * 784 + (16 * g + 8 * hh) * 2);
            f32x16 X[4]; s5_tile(G.W, af, X, hr0, hi0, hr1, hi1);
#pragma unroll
            for (int nt = 0; nt < 4; ++nt)
#pragma unroll
                for (int g4 = 0; g4 < 4; ++g4) { u32x2 pk; pk.x = cvtpk(X[nt][4 * g4], X[nt][4 * g4 + 1]); pk.y = cvtpk(X[nt][4 * g4 + 2], X[nt][4 * g4 + 3]);
                    *(LAS u32x2*)(img + nt * 2048 + l31 * 64 + 8 * (2 * g4 + hh)) = pk; }
            LDS_WAIT(); asm volatile("" ::: "memory");
            f32x16 Y = zero16();
            const int i16 = F.lane & 15, q = i16 >> 2, pp = i16 & 3, blk = (F.lane >> 4) & 1;
#pragma unroll
            for (int nt = 0; nt < 4; ++nt)
#pragma unroll
                for (int s = 0; s < 2; ++s) {
                    const s16x4 lo = __builtin_bit_cast(s16x4, __builtin_amdgcn_ds_read_tr16_b64_v4i16((LAS s16x4*)(img + nt * 2048 + (16 * s + 8 * hh + q) * 64 + 8 * (4 * blk + pp))));
                    const s16x4 hi4 = __builtin_bit_cast(s16x4, __builtin_amdgcn_ds_read_tr16_b64_v4i16((LAS s16x4*)(img + nt * 2048 + (16 * s + 8 * hh + 4 + q) * 64 + 8 * (4 * blk + pp))));
                    const bf16x8 xa = __builtin_shufflevector(lo, hi4, 0, 1, 2, 3, 4, 5, 6, 7);
                    Y = mfma32(xa, G.cf[2 * nt + s], Y);
                }
            LDS_WAIT(); asm volatile("" ::: "memory");
            if (l31 < 16) {
                const int chn = 16 * g + l31; unsigned ur[16];
#pragma unroll
                for (int rg = 0; rg < 16; ++rg) ur[rg] = *(const LAS unsigned short*)(Gs + (32 * hh + 16 * k + rg) * 784 + chn * 2);
                asm volatile("" : "+v"(ur[0]), "+v"(ur[1]), "+v"(ur[2]), "+v"(ur[3]), "+v"(ur[4]), "+v"(ur[5]), "+v"(ur[6]), "+v"(ur[7]),
                                  "+v"(ur[8]), "+v"(ur[9]), "+v"(ur[10]), "+v"(ur[11]), "+v"(ur[12]), "+v"(ur[13]), "+v"(ur[14]), "+v"(ur[15]));
                float gv[16];
#pragma unroll
                for (int rg = 0; rg < 16; ++rg) gv[rg] = gelu_t(Y[rg] + G.dsk * __uint_as_float(ur[rg] << 16));
#pragma unroll
                for (int rg = 0; rg < 16; ++rg) *(LAS unsigned short*)(Gs + (32 * hh + 16 * k + rg) * 784 + chn * 2) = f2bf1(gv[rg]);
            }
        }
        if (sc == 255) { const size_t o = ((size_t)(layer * NBATCH + hh) * NG + g) * NP + l31;
            F.out[OUT_SRP + o] = hr0; F.out[OUT_SIP + o] = hi0; F.out[OUT_SRP + o + 32] = hr1; F.out[OUT_SIP + o + 32] = hi1; }
    }
    __syncthreads();
    glu_tile(args, F, layer, Gs, t0);
}

typedef short s16x16 __attribute__((ext_vector_type(16)));
#define PIN8(v, o) "+v"(v[o]), "+v"(v[o + 1]), "+v"(v[o + 2]), "+v"(v[o + 3]), "+v"(v[o + 4]), "+v"(v[o + 5]), "+v"(v[o + 6]), "+v"(v[o + 7])
template <int N, class T> DI void pin_frags(T (&v)[N]) {
    static_assert(N == 3 || N == 8 || N == 22, "pin_frags: unsupported count");
    if constexpr (N == 3) asm volatile("" : "+v"(v[0]), "+v"(v[1]), "+v"(v[2]));
    else if constexpr (N == 8) asm volatile("" : PIN8(v, 0));
    else asm volatile("" : PIN8(v, 0), PIN8(v, 8), "+v"(v[16]), "+v"(v[17]), "+v"(v[18]), "+v"(v[19]), "+v"(v[20]), "+v"(v[21]));
}
template <int TM, int KSTEPS, int UNR> DI void mini_mma(Frame& F, const bf16* A, int r0, const bf16* brow) {
    constexpr int K = KSTEPS * 16 * 8;
    const int l31 = F.lane & 31, hh = F.lane >> 5, w = F.wave, k0 = w * (KSTEPS * 16);
    f32x16 acc[TM / 32];
#pragma unroll
    for (int mt = 0; mt < TM / 32; ++mt) acc[mt] = zero16();
    const bf16* ap = A + (size_t)(r0 + l31) * K + k0 + 8 * hh; const bf16* bp = brow + k0 + 8 * hh;
    s16x16 ab[KSTEPS]; bf16x8 a1[TM == 64 ? KSTEPS : 1];
#pragma unroll
    for (int s = 0; s < KSTEPS; ++s) {
        const bf16x8 b = *(const bf16x8*)(bp + 16 * s), a = *(const bf16x8*)(ap + 16 * s);
        ab[s] = __builtin_shufflevector(a, b, 0, 1, 2, 3, 4, 5, 6, 7, 8, 9, 10, 11, 12, 13, 14, 15);
        if constexpr (TM == 64) a1[s] = *(const bf16x8*)(ap + (size_t)32 * K + 16 * s);
    }
    pin_frags<KSTEPS>(ab);
    if constexpr (TM == 64) pin_frags<KSTEPS>(a1);
#pragma unroll
    for (int s = 0; s < KSTEPS; ++s) {
        const bf16x8 a = __builtin_shufflevector(ab[s], ab[s], 0, 1, 2, 3, 4, 5, 6, 7), b = __builtin_shufflevector(ab[s], ab[s], 8, 9, 10, 11, 12, 13, 14, 15);
        acc[0] = mfma32(a, b, acc[0]);
        if constexpr (TM == 64) acc[TM / 32 - 1] = mfma32(a1[s], b, acc[TM / 32 - 1]);
    }
    LAS float* part = (LAS float*)F.lds + w * (TM * 33);
#pragma unroll
    for (int mt = 0; mt < TM / 32; ++mt)
#pragma unroll
        for (int rg = 0; rg < 16; ++rg) part[(32 * mt + crow(rg, hh)) * 33 + l31] = acc[mt][rg];
    __syncthreads();
}
template <int TM> DI void mini_sum8(Frame& F, int row, int c8, float (&v)[8]) {
    const LAS float* part = (const LAS float*)F.lds + row * 33 + 8 * c8;
    float pv[8][8];
#pragma unroll
    for (int w = 0; w < 8; ++w)
#pragma unroll
        for (int e = 0; e < 8; ++e) pv[w][e] = part[w * (TM * 33) + e];
#pragma unroll
    for (int w = 0; w < 8; w += 2)
        asm volatile("" : "+v"(pv[w][0]), "+v"(pv[w][1]), "+v"(pv[w][2]), "+v"(pv[w][3]), "+v"(pv[w][4]), "+v"(pv[w][5]), "+v"(pv[w][6]), "+v"(pv[w][7]),
                          "+v"(pv[w + 1][0]), "+v"(pv[w + 1][1]), "+v"(pv[w + 1][2]), "+v"(pv[w + 1][3]), "+v"(pv[w + 1][4]), "+v"(pv[w + 1][5]), "+v"(pv[w + 1][6]), "+v"(pv[w + 1][7]));
#pragma unroll
    for (int e = 0; e < 8; ++e) v[e] = ((pv[0][e] + pv[1][e]) + (pv[2][e] + pv[3][e])) + ((pv[4][e] + pv[5][e]) + (pv[6][e] + pv[7][e]));
}
DI void glu_sample_tile(const Args& args, Frame& F, int layer, int tile) {
    launder(F);
    const int mt = tile & 7, nt = tile >> 3, r0 = 32 * mt, n0 = 32 * nt;
    const bf16* gsm = (const bf16*)(F.ws + WS_GSMP);
    const bf16* wg = (const bf16*)(F.ws + WS_WGLU + (size_t)layer * WGLU_STRIDE);
    mini_mma<32, 3, 3>(F, gsm, r0, wg + (size_t)(n0 + (F.lane & 31)) * BW);
    if (F.tid < 128) { const int row = F.tid >> 2, c8 = F.tid & 3, c0 = n0 + 8 * c8;
        float v[8]; mini_sum8<32>(F, row, c8, v);
        const u32x4 rw = *(const u32x4*)(gsm + (size_t)(r0 + row) * BW + c0);
        const float* bg = args.in[20] + (size_t)layer * BW + c0; const f32x4 b0 = *(const f32x4*)bg, b1 = *(const f32x4*)(bg + 4);
        const float gv[8] = {__uint_as_float(rw.x << 16), __uint_as_float(rw.x & 0xffff0000u), __uint_as_float(rw.y << 16), __uint_as_float(rw.y & 0xffff0000u),
                             __uint_as_float(rw.z << 16), __uint_as_float(rw.z & 0xffff0000u), __uint_as_float(rw.w << 16), __uint_as_float(rw.w & 0xffff0000u)};
        const float bb[8] = {b0.x, b0.y, b0.z, b0.w, b1.x, b1.y, b1.z, b1.w};
        float o[8];
#pragma unroll
        for (int e2 = 0; e2 < 8; ++e2) o[e2] = gv[e2] * sigmoid_f(v[e2] + bb[e2]);
        store8_bf16((bf16*)(F.ws + WS_MIX) + (size_t)(MP + r0 + row) * DM + AW + c0, o); }
    __syncthreads();
}

DI void mini_in_tile(const Args& args, Frame& F, int layer, int tile) {
    launder(F);
    const int mt = tile & 3, nt = tile >> 2, r0 = MP + 64 * mt, n0 = 32 * nt;
    const bf16* W = (const bf16*)(F.ws + WS_W + (size_t)layer * W_STRIDE + W_IN);
    float rstd; f32x4 t0 = (f32x4){1.f, 0.f, 1.f, 0.f}, t1 = t0;
    { const int row = (F.tid & 255) >> 2, c8 = F.tid & 3, grow = r0 + row, c0 = n0 + 8 * c8, hd = (c0 - O_Q) & 63;
      rstd = row_rstd((const float*)(F.ws + WS_RSS), grow);
      if (c0 >= O_Q && c0 < O_VV && hd < 16) { const f32x4* rp = (const f32x4*)((const f32x2*)(F.ws + WS_ROPE) + (size_t)row_pos(grow) * 8 + (hd >> 1)); t0 = rp[0]; t1 = rp[1]; } }
    mini_mma<64, 8, 8>(F, (const bf16*)(F.ws + WS_XB), r0, W + (size_t)(n0 + (F.lane & 31)) * DM);
    if (F.tid < 256) { const int row = F.tid >> 2, c8 = F.tid & 3, grow = r0 + row, c0 = n0 + 8 * c8;
        float v[8]; mini_sum8<64>(F, row, c8, v);
#pragma unroll
        for (int e = 0; e < 8; ++e) v[e] *= rstd;
        epi_in_apply(grow, c0, v, t0, t1, (bf16*)(F.ws + WS_PROJ), F.out, layer); }
    __syncthreads();
}
DI void mini_res_tile(const Args& args, Frame& F, int layer, int tile, const bf16* A, int K, const bf16* W, int first, int wf32) {
    launder(F);
    const int mt = tile & 7, nt = tile >> 3, r0 = MP + 32 * mt, n0 = 32 * nt;
    float* X = (float*)(F.ws + WS_X); bf16* XBp = (bf16*)(F.ws + WS_XB);
    f32x4 a0 = (f32x4){0.f, 0.f, 0.f, 0.f}, a1 = a0;
    { const int row = (F.tid & 127) >> 2, c8 = F.tid & 3, grow = r0 + row, c0 = n0 + 8 * c8;
      if (first) { const float* src = args.in[1] + (size_t)(grow - MP) * DM; a0 = *(const f32x4*)(src + c0); a1 = *(const f32x4*)(src + c0 + 4); }
      else { const u32x4 rw = *(const u32x4*)(XBp + (size_t)grow * DM + c0);
          a0 = (f32x4){__uint_as_float(rw.x << 16), __uint_as_float(rw.x & 0xffff0000u), __uint_as_float(rw.y << 16), __uint_as_float(rw.y & 0xffff0000u)};
          a1 = (f32x4){__uint_as_float(rw.z << 16), __uint_as_float(rw.z & 0xffff0000u), __uint_as_float(rw.w << 16), __uint_as_float(rw.w & 0xffff0000u)}; } }
    if (K == DM) mini_mma<32, 8, 8>(F, A, r0, W + (size_t)(n0 + (F.lane & 31)) * K); else mini_mma<32, 22, 22>(F, A, r0, W + (size_t)(n0 + (F.lane & 31)) * K);
    if (F.tid < 128) { const int row = F.tid >> 2, c8 = F.tid & 3, grow = r0 + row, c0 = n0 + 8 * c8;
        float v[8]; mini_sum8<32>(F, row, c8, v);
        float ss = 0.f;
#pragma unroll
        for (int e = 0; e < 4; ++e) { v[e] += a0[e]; v[4 + e] += a1[e]; }
#pragma unroll
        for (int e = 0; e < 8; ++e) ss += v[e] * v[e];
        if (wf32) { *(f32x4*)(X + (size_t)grow * DM + c0) = (f32x4){v[0], v[1], v[2], v[3]}; *(f32x4*)(X + (size_t)grow * DM + c0 + 4) = (f32x4){v[4], v[5], v[6], v[7]}; }
        store8_bf16(XBp + (size_t)grow * DM + c0, v);
        ss += __shfl_xor(ss, 1); ss += __shfl_xor(ss, 2);
        if (c8 == 0) ((float*)(F.ws + WS_RSS))[(size_t)grow * 32 + nt] = ss; }
    __syncthreads();
}
DI void mini_up_tile(const Args& args, Frame& F, int layer, int tile) {
    launder(F);
    const int mt = tile & 3, nt = tile >> 2, r0 = MP + 64 * mt, j0 = 16 * nt, l31 = F.lane & 31;
    const bf16* W = (const bf16*)(F.ws + WS_W + (size_t)layer * W_STRIDE + W_UP);
    const int jl = j0 + (l31 & 15), prow = 256 * (jl >> 7) + 128 * (l31 >> 4) + (jl & 127);
    mini_mma<64, 8, 8>(F, (const bf16*)(F.ws + WS_XB), r0, W + (size_t)prow * DM);
    LAS float* hbuf = (LAS float*)F.lds + 8 * (64 * 33);
    if (F.tid < 256) { const int row = F.tid >> 2, c8 = F.tid & 3, grow = r0 + row;
        float v[8]; mini_sum8<64>(F, row, c8, v);
        const float rstd = row_rstd((const float*)(F.ws + WS_RSS), grow);
#pragma unroll
        for (int e = 0; e < 8; ++e) { v[e] *= rstd; hbuf[row * 33 + 8 * c8 + e] = v[e]; }
        const int rs = grow - MP, sb = rs >> 3, t = rs & 7, cl = (c8 >> 1) * DFF + j0 + 8 * (c8 & 1);
        if (t >= STOK - 2) { float* sd = F.out + OUT_FCS + (((size_t)layer * SBATCH + sb) * 2 + (t - (STOK - 2))) * DFF2 + cl;
            *(f32x4*)sd = (f32x4){v[0], v[1], v[2], v[3]}; *(f32x4*)(sd + 4) = (f32x4){v[4], v[5], v[6], v[7]}; } }
    __syncthreads();
    if (F.tid < 128) { const int row = F.tid >> 1, jc = F.tid & 1, grow = r0 + row, rs = grow - MP, sb = rs >> 3, t = rs & 7;
        const float* cw = args.in[24] + (size_t)layer * 3 * DFF2; const float* cb = args.in[25] + (size_t)layer * DFF2;
        const float* sbuf = args.in[6] + ((size_t)layer * SBATCH + sb) * 2 * DFF2;
        float o[8];
#pragma unroll
        for (int e = 0; e < 8; ++e) { const int j = j0 + 8 * jc + e; float hc[2];
#pragma unroll
            for (int half = 0; half < 2; ++half) { const int col = half * DFF + j, lc = 16 * half + 8 * jc + e; float a = cb[col];
#pragma unroll
                for (int tap = 0; tap < 3; ++tap) { const int back = 2 - tap; const float hv = (t - back >= 0) ? hbuf[(row - back) * 33 + lc] : sbuf[(size_t)(t - back + 2) * DFF2 + col]; a += cw[(size_t)tap * DFF2 + col] * hv; }
                hc[half] = a; }
            o[e] = gelu_t(hc[0]) * hc[1]; }
        store8_bf16((bf16*)(F.ws + WS_A2) + (size_t)grow * DFF + j0 + 8 * jc, o); }
    __syncthreads();
}

DI void final_norm(const Args& args, Frame& F) {
    launder(F);
    const bf16* XB = (const bf16*)(F.ws + WS_XB); const float* rss = (const float*)(F.ws + WS_RSS); const float* fg = args.in[27];
    const int gw = F.bid * NWAVES + F.wave, NGW = F.G * NWAVES;
    for (int row = gw; row < MR; row += NGW) { const float rstd = row_rstd(rss, row);
        float* o = row < MP ? F.out + OUT_YP + (size_t)row * DM : F.out + OUT_YS + (size_t)(row - MP) * DM;
#pragma unroll
        for (int jq = 0; jq < 2; ++jq) { const u32x4 rw = ((const u32x4*)(XB + (size_t)row * DM))[F.lane + 64 * jq]; const f32x4 g0 = ((const f32x4*)fg)[2 * (F.lane + 64 * jq)], g1 = ((const f32x4*)fg)[2 * (F.lane + 64 * jq) + 1];
            ((f32x4*)o)[2 * (F.lane + 64 * jq)] = (f32x4){__uint_as_float(rw.x << 16) * rstd * g0.x, __uint_as_float(rw.x & 0xffff0000u) * rstd * g0.y, __uint_as_float(rw.y << 16) * rstd * g0.z, __uint_as_float(rw.y & 0xffff0000u) * rstd * g0.w};
            ((f32x4*)o)[2 * (F.lane + 64 * jq) + 1] = (f32x4){__uint_as_float(rw.z << 16) * rstd * g1.x, __uint_as_float(rw.z & 0xffff0000u) * rstd * g1.y, __uint_as_float(rw.w << 16) * rstd * g1.z, __uint_as_float(rw.w & 0xffff0000u) * rstd * g1.w}; } }
}

constexpr int N_PHASES = 26;
#ifndef REP_P2
#define REP_P2 1
#endif
#ifndef REP_P1
#define REP_P1 1
#endif
#ifndef REP_AS
#define REP_AS 1
#endif
#ifndef PROBE_MODE
#define PROBE_MODE 0
#endif
#ifndef REP_P4
#define REP_P4 1
#endif
#ifndef REP_P6
#define REP_P6 1
#endif
#ifndef REP_S2
#define REP_S2 1
#endif
#ifndef REP_MG
#define REP_MG 1
#endif
#ifndef REP_AP
#define REP_AP 1
#endif
#ifndef REP_S1
#define REP_S1 1
#endif
#ifndef REP_SG
#define REP_SG 1
#endif
#ifndef REP_P5
#define REP_P5 1
#endif
#ifndef REP_CV
#define REP_CV 1
#endif
#ifndef REP_PRO
#define REP_PRO 1
#endif
#ifndef REP_P3
#define REP_P3 1
#endif

__global__ void __launch_bounds__(NTHR, 2) hymba_fwd(Args args) {
    extern __shared__ __attribute__((aligned(16))) unsigned char lds_raw[];
    Frame F;
    F.lds = (LAS unsigned char*)lds_raw;
    F.tid = threadIdx.x; F.lane = F.tid & 63; F.wave = __builtin_amdgcn_readfirstlane(F.tid >> 6); F.G = gridDim.x; F.bid = blockIdx.x;
    F.out = args.out; F.ws = args.ws;
    volatile LAS unsigned* MISC = (volatile LAS unsigned*)(F.lds + MISC_OFF);
    for (int u = F.tid; u < (LDS_BYTES - LDSCTL_OFF) / 4; u += NTHR) ((LAS unsigned*)(F.lds + LDSCTL_OFF))[u] = 0u;
    __syncthreads();
    unsigned* ctl = (unsigned*)(F.ws + WS_CTL);
    XcdBarrier bar = xcd_barrier_post(ctl + CW_BAR, MISC + 8);
    const int lo = args.ph_lo, hi = args.ph_hi;
#define IN(k) (lo <= (k) && (k) < hi)
#if defined(STAMP_A)
#define SEAM(k) do { if (IN(k) && IN((k) + 1)) { xcd_barrier(bar); if (F.bid == 0 && F.tid == 0) ((unsigned long long*)(F.ws + WS_CTL + 524288))[(k) + 1] = __builtin_amdgcn_s_memrealtime(); } } while (0)
#else
#define SEAM(k) do { if (IN(k) && IN((k) + 1)) xcd_barrier(bar); } while (0)
#endif

    #ifndef DIS_PRO
    for (int rep_ = 0; rep_ < REP_PRO; ++rep_) if (IN(0)) { if (rep_) { __syncthreads(); } prologue(args, F); }
#endif
    SEAM(0);

    for (int l = 0; l < DEPTH; ++l) {
        const int pb = 1 + 6 * l;
#ifndef DIS_G1
        for (int rep_ = 0; rep_ < REP_P1; ++rep_) if (IN(pb + 0)) { if (rep_) { __syncthreads(); } const int ll = launder_i(l); unsigned char* wl = F.ws + WS_W + (size_t)ll * W_STRIDE; (void)wl;
            pg8::Gemm g{(const bf16*)(F.ws + WS_XB), (const bf16*)(wl + W_IN), MP, INW, DM}; pg8::StaticOrder S; S.init(MP, INW, launder_i(F.G), launder_i(F.bid));
            build_rstd_table(F, S, (const float*)(F.ws + WS_RSS));
            EpiIn E{(bf16*)(F.ws + WS_PROJ), (const LAS float*)(F.lds + RSTD_OFF), (const f32x2*)(F.ws + WS_ROPE), F.out, ll};
            pg8::gemm_phase<EpiIn, pg8::StaticOrder, true, true>(F.lds, g, S, E, launder_i(F.wave));
            for (int t = F.bid; t < 256; t += F.G) mini_in_tile(args, F, ll, t);
        }
#endif
        SEAM(pb + 0);
#ifndef DIS_P2
        for (int rep_ = 0; rep_ < REP_P2; ++rep_) if (IN(pb + 1)) { if (rep_) { __syncthreads(); } const int ll = launder_i(l); unsigned char* wl = F.ws + WS_W + (size_t)ll * W_STRIDE; (void)wl;
#define DEAL(start, count) for (int gi_ = (start) + (((F.bid - (start)) % F.G) + F.G) % F.G, u = gi_ - (start); gi_ < (start) + (count); gi_ += F.G, u += F.G)
            if (F.bid & 1) {
                attn_prompt_phase(F, F.bid, 1152, F.G);
                DEAL(0, 576) attn_sample_unit(args, F, ll, u);
            } else {
                DEAL(0, 576) attn_sample_unit(args, F, ll, u);
                attn_prompt_phase(F, F.bid, 1152, F.G);
            }
            {   unsigned* qc = ctl + CW_Q + 64 * ll;
                volatile LAS unsigned* qs = MISC + 10;
                if (threadIdx.x == 0) qs[0] = xb_add(qc, 1u);
                __syncthreads();
                unsigned cur = qs[0];
                __syncthreads();
                while (cur < 448u) {
                    if (threadIdx.x == 0) qs[0] = xb_add(qc, 1u);
                    const int tk = __builtin_amdgcn_readfirstlane((int)cur);
                    if (tk < 128) sgu_prompt_unit(args, F, ll, tk);
                    else if (tk < 320) { const int u = tk - 128; s5_pass1_unit(F, ll, u / NG, u % NG); }
                    else if (tk < 416) s5_sample_unit(args, F, ll, tk - 320);
                    else sgu_sample_unit(args, F, ll, tk - 416);
                    cur = qs[0];
                    __syncthreads();
                }
            }
#undef DEAL
        }
#endif
        SEAM(pb + 1);
#ifndef DIS_P3
        for (int rep_ = 0; rep_ < REP_P3; ++rep_) if (IN(pb + 2)) { if (rep_) { __syncthreads(); } const int ll = launder_i(l); unsigned char* wl = F.ws + WS_W + (size_t)ll * W_STRIDE; (void)wl;
#ifndef DIS_U_S2
            for (int r2_ = 0; r2_ < REP_S2; ++r2_) for (int u = F.bid; u < 256; u += F.G) s5_pass2_unit(args, F, ll, u);
#endif
#if defined(STAMP_A)
            if (l == 1 && F.bid == 0 && F.wave == 0) ((unsigned long long*)(F.ws + WS_CTL + 524288))[40] = __builtin_amdgcn_s_memrealtime();
#endif
            for (int u = F.bid; u < 96; u += F.G) glu_sample_tile(args, F, ll, u);
#ifndef DIS_U_MG
            for (int r2_ = 0; r2_ < REP_MG; ++r2_) attn_merge(F);
            attn_sample_merge(F);
#endif
#if defined(STAMP_A)
            if (l == 1 && F.bid == 0 && F.wave == 0) ((unsigned long long*)(F.ws + WS_CTL + 524288))[41] = __builtin_amdgcn_s_memrealtime();
#endif

        }
#endif
        SEAM(pb + 2);
#ifndef DIS_G4
        for (int rep_ = 0; rep_ < REP_P4; ++rep_) if (IN(pb + 3)) { if (rep_) { __syncthreads(); } const int ll = launder_i(l); unsigned char* wl = F.ws + WS_W + (size_t)ll * W_STRIDE; (void)wl;
            pg8::Gemm g{(const bf16*)(F.ws + WS_MIX), (const bf16*)(wl + W_OUT), MP, DM, DM}; pg8::StaticOrder S; S.init(MP, DM, launder_i(F.G), launder_i(F.bid));
            EpiRes E{args.in[0], args.in[1], (float*)(F.ws + WS_X), (bf16*)(F.ws + WS_XB), (float*)(F.ws + WS_RSS), ll == 0 ? 1 : 0, rep_ + 1 < REP_P4 ? 1 : 0, 0};
            if (rep_ + 1 < REP_P4) { pg8::gemm_phase<EpiRes, pg8::StaticOrder, true, true>(F.lds, g, S, E, launder_i(F.wave)); continue; }
            pg8::gemm_phase<EpiRes, pg8::StaticOrder, true, true>(F.lds, g, S, E, launder_i(F.wave));
            for (int t = F.bid; t < 256; t += F.G) mini_res_tile(args, F, ll, t, (const bf16*)(F.ws + WS_MIX), DM, (const bf16*)(wl + W_OUT), ll == 0 ? 1 : 0, 0);
        }
#endif
        SEAM(pb + 3);
#ifndef DIS_G5
        for (int rep_ = 0; rep_ < REP_P5; ++rep_) if (IN(pb + 4)) { if (rep_) { __syncthreads(); } const int ll = launder_i(l); unsigned char* wl = F.ws + WS_W + (size_t)ll * W_STRIDE;
            pg8::Gemm g{(const bf16*)(F.ws + WS_XB), (const bf16*)(wl + W_UP), UP_PANELS * 256, DFF2, DM}; UpOrder S; S.init(UP_PANELS * 256, DFF2, launder_i(F.G), launder_i(F.bid));
            build_rstd_table_up(F, S, (const float*)(F.ws + WS_RSS), args.in[24] + (size_t)ll * 3 * DFF2, args.in[25] + (size_t)ll * DFF2);
            EpiUpConv E{(bf16*)(F.ws + WS_A2), (const LAS float*)(F.lds + RSTD_OFF), (LAS float*)(F.lds + XCH_OFF), args.in[24] + (size_t)ll * 3 * DFF2, args.in[25] + (size_t)ll * DFF2, args.in[6], F.out, ll, 0};
#if PROBE_MODE == 1
            if (rep_ + 1 < REP_P5) { EpiUpConv E1 = E; E1.mode = 1; pg8::gemm_phase<EpiUpConv, UpOrder, true, true>(F.lds, g, S, E1, launder_i(F.wave)); continue; }
#elif PROBE_MODE == 2
            if (rep_ + 1 < REP_P5) { EpiStoreOnly ES{(bf16*)(F.ws + WS_A2)}; pg8::gemm_phase<EpiStoreOnly, UpOrder, true, true>(F.lds, g, S, ES, launder_i(F.wave)); continue; }
#else
            if (rep_ + 1 < REP_P5) { EpiNull EN{(float*)(F.ws + WS_OPS)}; pg8::gemm_phase<EpiNull, UpOrder, true, true>(F.lds, g, S, EN, launder_i(F.wave)); continue; }
#endif
            pg8::gemm_phase<EpiUpConv, UpOrder, true, true>(F.lds, g, S, E, launder_i(F.wave));
            { const int heavy = (UP_PANELS * 22) % F.G, nfree = F.G - SMP_UNITS - heavy;
              if (ll + 1 < DEPTH && rep_ == 0) { if (heavy > 0 && nfree >= 16) { if (F.bid >= heavy && F.bid < F.G - SMP_UNITS) convert_layer_weights(args, F, ll + 1, heavy, nfree); } else convert_layer_weights(args, F, ll + 1, 0, F.G); } }
            { SmpOrder SS{launder_i(F.G), launder_i(F.bid)};
              const int pre_ = (F.bid >= F.G - 22 && F.bid >= (UP_PANELS * 22) % F.G && (UP_PANELS * 22) % F.G > 0) ? 1 : 0;
              EpiUpSample ES{(bf16*)(F.ws + WS_A2), (LAS float*)(F.lds + RSTD_OFF) + (pre_ ? 5 * 256 : 0), (const float*)(F.ws + WS_RSS), args.in[24] + (size_t)ll * 3 * DFF2, args.in[25] + (size_t)ll * DFF2, args.in[6], F.out, ll, pre_};
              pg8::gemm_phase<EpiUpSample, SmpOrder, false, true>(F.lds, g, SS, ES, launder_i(F.wave)); }
        }
#endif
        SEAM(pb + 4);
#ifndef DIS_G6
        for (int rep_ = 0; rep_ < REP_P6; ++rep_) if (IN(pb + 5)) { if (rep_) { __syncthreads(); } const int ll = launder_i(l); unsigned char* wl = F.ws + WS_W + (size_t)ll * W_STRIDE; (void)wl;
            pg8::Gemm g{(const bf16*)(F.ws + WS_A2), (const bf16*)(wl + W_DOWN), MP, DM, DFF}; pg8::StaticOrder S; S.init(MP, DM, launder_i(F.G), launder_i(F.bid));
            EpiRes E{args.in[0], args.in[1], (float*)(F.ws + WS_X), (bf16*)(F.ws + WS_XB), (float*)(F.ws + WS_RSS), 0, rep_ + 1 < REP_P6 ? 1 : 0, 0};
            if (rep_ + 1 < REP_P6) { pg8::gemm_phase<EpiRes, pg8::StaticOrder, true, true>(F.lds, g, S, E, launder_i(F.wave)); continue; }
            pg8::gemm_phase<EpiRes, pg8::StaticOrder, true, true>(F.lds, g, S, E, launder_i(F.wave));
            for (int t = F.bid; t < 256; t += F.G) mini_res_tile(args, F, ll, t, (const bf16*)(F.ws + WS_A2), DFF, (const bf16*)(wl + W_DOWN), 0, 0);
        }
#endif
        SEAM(pb + 5);
    }
    if (IN(25)) { final_norm(args, F); }
#if defined(STAMP_A)
    if (F.bid == 0) { const unsigned long long* st = (const unsigned long long*)(F.ws + WS_CTL + 524288);
        const float tus = (float)(st[STAMP_B] - st[STAMP_A]) * 0.01f, s = 1.0f + tus / (float)(STAMP_REF);
        for (int i = F.tid; i < DEPTH * NBATCH * NG * NP; i += NTHR) F.out[OUT_SRP + i] *= s; }
#endif
#undef IN
#undef SEAM
}

#ifndef MK_SPLIT
#define MK_SPLIT 0
#endif
extern "C" void kernel_launch(void* const* d_in, const int* in_sizes, int n_in, void* d_out, int out_size, void* d_ws, size_t ws_size, hipStream_t stream) {
    static int grid = 0;
    if (grid == 0) {
        if (n_in != 28 || (size_t)out_size != OUT_END || ws_size < WS_END) { fprintf(stderr, "kernel_launch: unexpected shapes: n_in %d out %d (want %zu) ws %zu (want %zu)\n", n_in, out_size, (size_t)OUT_END, ws_size, (size_t)WS_END); grid = -1; return; }
        int dev = 0, cus = 0, per_cu = 0;
        if (hipGetDevice(&dev) != hipSuccess || hipDeviceGetAttribute(&cus, hipDeviceAttributeMultiprocessorCount, dev) != hipSuccess) { grid = -1; return; }
        if (hipFuncSetAttribute((const void*)hymba_fwd, hipFuncAttributeMaxDynamicSharedMemorySize, LDS_BYTES) != hipSuccess) { fprintf(stderr, "kernel_launch: hipFuncSetAttribute failed\n"); grid = -1; return; }
        if (hipOccupancyMaxActiveBlocksPerMultiprocessor(&per_cu, (const void*)hymba_fwd, NTHR, LDS_BYTES) != hipSuccess || per_cu < 1) { fprintf(stderr, "kernel_launch: occupancy query says %d\n", per_cu); }
        (void)hipGetLastError();
        grid = cus;
    }
    if (grid < 0) return;
    (void)hipMemsetAsync((char*)d_ws + WS_CTL, 0, CTL_ZERO_BYTES, stream);
    Args a{};
    for (int i = 0; i < 28; ++i) a.in[i] = (const float*)d_in[i];
    a.out = (float*)d_out; a.ws = (unsigned char*)d_ws;
#if MK_SPLIT
    for (int p = 0; p < N_PHASES; ++p) { a.ph_lo = p; a.ph_hi = p + 1; hipLaunchKernelGGL(hymba_fwd, dim3(grid), dim3(NTHR), LDS_BYTES, stream, a); }
#else
    a.ph_lo = 0; a.ph_hi = N_PHASES;
    hipLaunchKernelGGL(hymba_fwd, dim3(grid), dim3(NTHR), LDS_BYTES, stream, a);
#endif
}
```
